# Optimizing an MI355X kernel written in HIP

```python
import math
import jax, jax.numpy as jnp
from jax import lax
import numpy as np

D_MODEL = 1024
BATCH = 8
SEQ = 2048
DEPTH = 2

GRID_W = 64
CTX_LEN = 256
EPS = 1e-6
N_MOD = 6

N_HEADS = 8
N_KV_HEADS = 2
GQA = N_HEADS // N_KV_HEADS
HEAD_DIM = 64
WINDOW = 128
ATT_BLOCK = 128
ROPE_BASE = 10000.0
ROPE_AXIS_PAIRS = HEAD_DIM // 4

S5_GROUPS = 16
S5_GROUP_CH = 16
S5_STATE = 64
S5_W = S5_GROUPS * S5_GROUP_CH

RET_HEADS = 4
RET_HEAD_DIM = 64
RET_W = RET_HEADS * RET_HEAD_DIM
RET_CHUNK = 128
RET_ROPE_BASE = 10000.0

ATT_Q_W = N_HEADS * HEAD_DIM
ATT_KV_W = N_KV_HEADS * HEAD_DIM
MIX_W = ATT_Q_W + S5_W + RET_W
PROJ_W = ATT_Q_W + 2 * ATT_KV_W + S5_W + 4 * RET_W

PEER_HEADS = 8
PEER_N_KEYS = 128
PEER_EXPERTS = PEER_N_KEYS * PEER_N_KEYS
PEER_QUERY_DIM = 128
PEER_HALF = PEER_QUERY_DIM // 2
PEER_TOPK = 16
PEER_TOKEN_BLOCK = 128

kernel_name = "hybrid_flow_backbone_attn_s5_retention_peer"

F32 = jnp.float32


def rms_norm(x, w):
    xf = x.astype(F32)
    y = xf * lax.rsqrt(jnp.mean(xf * xf, axis=-1, keepdims=True) + EPS)
    return (y * w).astype(x.dtype)


def modulate(x, shift, scale):
    return x * (1.0 + scale) + shift


def adaln_params(cvec, w, b):
    m = jax.nn.silu(cvec) @ w + b
    return m.reshape(cvec.shape[:-1] + (N_MOD, D_MODEL))


def split_projection(z):
    sizes = (ATT_Q_W, ATT_KV_W, ATT_KV_W, S5_W, RET_W, RET_W, RET_W, RET_W)
    offsets = [sum(sizes[:i]) for i in range(1, len(sizes))]
    return jnp.split(z, offsets, axis=-1)


def axial_rope_tables(rows):
    t = jnp.arange(rows * GRID_W)
    r = (t // GRID_W).astype(F32)
    col = (t % GRID_W).astype(F32)
    inv = ROPE_BASE ** (-jnp.arange(ROPE_AXIS_PAIRS, dtype=F32) / ROPE_AXIS_PAIRS)
    ang = jnp.concatenate([r[:, None] * inv, col[:, None] * inv], axis=-1)
    return jnp.cos(ang), jnp.sin(ang)


def flat_rope_tables(length, dim):
    t = jnp.arange(length, dtype=F32)
    inv = RET_ROPE_BASE ** (-jnp.arange(dim // 2, dtype=F32) / (dim // 2))
    ang = t[:, None] * inv
    return jnp.cos(ang), jnp.sin(ang)


def apply_rope(x, cos, sin):
    half = x.shape[-1] // 2
    bshape = (1, cos.shape[0]) + (1,) * (x.ndim - 3) + (half,)
    cos = cos.reshape(bshape)
    sin = sin.reshape(bshape)
    xf = x.astype(F32)
    x1, x2 = xf[..., :half], xf[..., half:]
    return jnp.concatenate([x1 * cos - x2 * sin, x1 * sin + x2 * cos], axis=-1).astype(x.dtype)


def window_attention(q, k, v, kc, vc, sink_logit):
    b, n = q.shape[:2]
    nb = n // ATT_BLOCK
    qb = q.reshape(b, nb, ATT_BLOCK, N_KV_HEADS, GQA, HEAD_DIM)

    def band(t):
        tp = jnp.pad(t, ((0, 0), (ATT_BLOCK, ATT_BLOCK), (0, 0), (0, 0)))
        tp = tp.reshape(b, nb + 2, ATT_BLOCK, N_KV_HEADS, HEAD_DIM)
        return jnp.concatenate([tp[:, :-2], tp[:, 1:-1], tp[:, 2:]], axis=2)

    kw, vw = band(k), band(v)
    nw = 3 * ATT_BLOCK
    s_win = jnp.einsum('bnqhgd,bnkhd->bnhgqk', qb, kw).astype(F32)
    qi = jnp.arange(ATT_BLOCK)[:, None]
    kj = jnp.arange(nw)[None, :]
    key_pos = jnp.arange(nb)[:, None, None] * ATT_BLOCK - ATT_BLOCK + kj[None]
    valid = (jnp.abs(kj - ATT_BLOCK - qi) <= WINDOW)[None] & (key_pos >= 0) & (key_pos < n)
    s_win = jnp.where(valid[None, :, None, None], s_win, -jnp.inf)
    s_ctx = jnp.einsum('bnqhgd,bchd->bnhgqc', qb, kc).astype(F32)
    s_sink = jnp.broadcast_to(sink_logit[None, None, :, :, None, None], s_ctx.shape[:-1] + (1,))
    p = jax.nn.softmax(jnp.concatenate([s_win, s_ctx, s_sink], axis=-1), axis=-1)
    p_win = p[..., :nw].astype(v.dtype)
    p_ctx = p[..., nw:-1].astype(v.dtype)
    o = (jnp.einsum('bnhgqk,bnkhd->bnqhgd', p_win, vw)
         + jnp.einsum('bnhgqc,bchd->bnqhgd', p_ctx, vc))
    return o.reshape(b, n, ATT_Q_W)


def context_attention(qc, kc, vc, sink_logit):
    b, n = qc.shape[:2]
    s = jnp.einsum('bqhgd,bkhd->bhgqk', qc, kc).astype(F32)
    s_sink = jnp.broadcast_to(sink_logit[None, :, :, None, None], s.shape[:-1] + (1,))
    p = jax.nn.softmax(jnp.concatenate([s, s_sink], axis=-1), axis=-1)[..., :-1].astype(vc.dtype)
    o = jnp.einsum('bhgqk,bkhd->bqhgd', p, vc)
    return o.reshape(b, n, ATT_Q_W)


def attention_group(zq, zk, zv, zqc, zkc, zvc, q_norm, k_norm, sink, cos, sin, need_ctx):
    scale = HEAD_DIM ** -0.5

    def prep(a, bk, cv):
        bsz, n = a.shape[:2]
        q = rms_norm(a.reshape(bsz, n, N_KV_HEADS, GQA, HEAD_DIM), q_norm)
        k = rms_norm(bk.reshape(bsz, n, N_KV_HEADS, HEAD_DIM), k_norm)
        v = cv.reshape(bsz, n, N_KV_HEADS, HEAD_DIM)
        return q, k, v

    q, k, v = prep(zq, zk, zv)
    q = apply_rope(q, cos, sin) * scale
    k = apply_rope(k, cos, sin)
    qc, kc, vc = prep(zqc, zkc, zvc)
    qc = qc * scale
    sink_logit = sink.astype(F32).reshape(N_KV_HEADS, GQA)
    out = window_attention(q, k, v, kc, vc, sink_logit)
    out_c = context_attention(qc, kc, vc, sink_logit) if need_ctx else None
    return out, out_c


def _ssm_combine(e_i, e_j):
    a_i, b_i = e_i
    a_j, b_j = e_j
    return a_j * a_i, a_j * b_i + b_j


def s5_discretize(a_re, a_im, log_dt, b_re, b_im):
    lam = lax.complex(a_re.astype(F32), a_im.astype(F32))
    dt = jnp.exp(log_dt.astype(F32))
    a_bar = jnp.exp(lam * dt)
    b = lax.complex(b_re.astype(F32), b_im.astype(F32))
    b_bar = ((a_bar - 1.0) / lam)[..., None] * b
    return a_bar, b_bar


def s5_scan(u, a_bar, b_bar, h0, reverse):
    bu = jnp.einsum('gph,blgh->blgp', b_bar, u.astype(jnp.complex64))
    idx = -1 if reverse else 0
    bu = bu.at[:, idx].add(a_bar * h0)
    a = jnp.broadcast_to(a_bar, bu.shape)
    _, hs = lax.associative_scan(_ssm_combine, (a, bu), reverse=reverse, axis=1)
    return hs


def s5_output(y, u, d, glu_w, glu_b):
    bsz, n = y.shape[:2]
    y = y.reshape(bsz, n, S5_W) + d * u
    y = jax.nn.gelu(y)
    return y * jax.nn.sigmoid(y @ glu_w + glu_b)


def s5_group(zu, zuc, a_re, a_im, log_dt, b_re, b_im, c_re, c_im, d, glu_w, glu_b, need_ctx):
    bsz, n = zu.shape[:2]
    nc = zuc.shape[1]
    u = zu.astype(F32)
    uc = zuc.astype(F32)
    ug = u.reshape(bsz, n, S5_GROUPS, S5_GROUP_CH)
    ucg = uc.reshape(bsz, nc, S5_GROUPS, S5_GROUP_CH)
    h0 = jnp.zeros((bsz, S5_GROUPS, S5_STATE), jnp.complex64)
    ys, ycs = [], []
    for direction in range(2):
        rev = direction == 1
        a_bar, b_bar = s5_discretize(a_re[direction], a_im[direction], log_dt[direction],
                                     b_re[direction], b_im[direction])
        cmat = lax.complex(c_re[direction].astype(F32), c_im[direction].astype(F32))
        hc = s5_scan(ucg, a_bar, b_bar, h0, rev)
        h_ctx_final = hc[:, 0] if rev else hc[:, -1]
        hl = s5_scan(ug, a_bar, b_bar, h_ctx_final, rev)
        ys.append(jnp.real(jnp.einsum('ghp,blgp->blgh', cmat, hl)))
        if need_ctx:
            ycs.append(jnp.real(jnp.einsum('ghp,blgp->blgh', cmat, hc)))
    out = s5_output(ys[0] + ys[1], u, d, glu_w, glu_b).astype(zu.dtype)
    out_c = s5_output(ycs[0] + ycs[1], uc, d, glu_w, glu_b).astype(zu.dtype) if need_ctx else None
    return out, out_c


def retention_chunkwise(q, k, v, log_gamma, s0):
    b, h, n, d = q.shape
    nc = n // RET_CHUNK
    qc = q.reshape(b, h, nc, RET_CHUNK, d)
    kc = k.reshape(b, h, nc, RET_CHUNK, d)
    vc = v.reshape(b, h, nc, RET_CHUNK, d)
    pos = jnp.arange(RET_CHUNK, dtype=F32)
    lg = log_gamma[:, None]
    rel = pos[:, None] - pos[None, :]
    intra_decay = jnp.where(rel >= 0, jnp.exp(lg[:, :, None] * jnp.maximum(rel, 0.0)), 0.0)
    scores = jnp.einsum('bhncd,bhnmd->bhncm', qc, kc) * intra_decay[None, :, None]
    intra = jnp.einsum('bhncm,bhnme->bhnce', scores, vc)
    k_w = jnp.exp(lg * (RET_CHUNK - 1 - pos))[None, :, None, :, None]
    kv = jnp.einsum('bhnmd,bhnme->bhnde', kc * k_w, vc)
    q_w = jnp.exp(lg * (pos + 1.0))[None, :, None, :, None]
    chunk_decay = jnp.exp(log_gamma * RET_CHUNK)[None, :, None, None]

    def step(s, kv_n):
        return chunk_decay * s + kv_n, s

    s_final, s_prev = lax.scan(step, s0, jnp.moveaxis(kv, 2, 0))
    cross = jnp.einsum('bhncd,nbhde->bhnce', qc * q_w, s_prev)
    return (intra + cross).reshape(b, h, n, d), s_final


def retention_output(o, zg):
    o = o * lax.rsqrt(jnp.mean(o * o, axis=-1, keepdims=True) + EPS)
    b, _, n, _ = o.shape
    o = jnp.swapaxes(o, 1, 2).reshape(b, n, RET_W)
    return (o * jax.nn.silu(zg.astype(F32))).astype(zg.dtype)


def retention_group(zq, zk, zv, zg, zqc, zkc, zvc, zgc, decay_logit, cos, sin, need_ctx):
    log_gamma = jax.nn.log_sigmoid(decay_logit.astype(F32))
    scale = RET_HEAD_DIM ** -0.5

    def heads(z):
        b, n = z.shape[:2]
        return z.astype(F32).reshape(b, n, RET_HEADS, RET_HEAD_DIM)

    q = jnp.swapaxes(apply_rope(heads(zq), cos, sin) * scale, 1, 2)
    k = jnp.swapaxes(apply_rope(heads(zk), cos, sin), 1, 2)
    v = jnp.swapaxes(heads(zv), 1, 2)
    qc = jnp.swapaxes(heads(zqc) * scale, 1, 2)
    kc = jnp.swapaxes(heads(zkc), 1, 2)
    vc = jnp.swapaxes(heads(zvc), 1, 2)
    s0 = jnp.zeros((q.shape[0], RET_HEADS, RET_HEAD_DIM, RET_HEAD_DIM), F32)

    def flip(t):
        return jnp.flip(t, axis=2)

    oc_f, sc_f = retention_chunkwise(qc, kc, vc, log_gamma[0], s0)
    o_f, _ = retention_chunkwise(q, k, v, log_gamma[0], sc_f)
    oc_b, sc_b = retention_chunkwise(flip(qc), flip(kc), flip(vc), log_gamma[1], s0)
    o_b, _ = retention_chunkwise(flip(q), flip(k), flip(v), log_gamma[1], sc_b)
    out = retention_output(o_f + flip(o_b), zg)
    out_c = retention_output(oc_f + flip(oc_b), zgc) if need_ctx else None
    return out, out_c


def peer_ffn(h, wq, sub_keys, u, v):
    shape = h.shape
    tok = h.reshape(-1, D_MODEL)
    blocks = tok.reshape(tok.shape[0] // PEER_TOKEN_BLOCK, PEER_TOKEN_BLOCK, D_MODEL)

    def block_fn(hb):
        q = (hb @ wq).reshape(PEER_TOKEN_BLOCK, PEER_HEADS, 2, PEER_HALF)
        s1 = jnp.einsum('thd,hkd->thk', q[:, :, 0], sub_keys[0]).astype(F32)
        s2 = jnp.einsum('thd,hkd->thk', q[:, :, 1], sub_keys[1]).astype(F32)
        t1, i1 = lax.top_k(s1, PEER_TOPK)
        t2, i2 = lax.top_k(s2, PEER_TOPK)
        cand = (t1[..., :, None] + t2[..., None, :]).reshape(PEER_TOKEN_BLOCK, PEER_HEADS, PEER_TOPK * PEER_TOPK)
        cidx = (i1[..., :, None] * PEER_N_KEYS + i2[..., None, :]).reshape(PEER_TOKEN_BLOCK, PEER_HEADS, PEER_TOPK * PEER_TOPK)
        best, sel = lax.top_k(cand, PEER_TOPK)
        eidx = jnp.take_along_axis(cidx, sel, axis=-1)
        gate = jax.nn.softmax(best, axis=-1)
        act = jax.nn.gelu(jnp.einsum('thkd,td->thk', u[eidx], hb).astype(F32))
        w = (gate * act).astype(hb.dtype)
        return jnp.einsum('thk,thkd->td', w, v[eidx])

    return lax.map(block_fn, blocks).reshape(shape)


def setup_inputs(seed: int = 0) -> dict:
    key = jax.random.key(seed)
    ks = jax.random.split(key, 32)

    def nrm(k, shape, scale):
        return jax.random.normal(k, shape, F32) * scale

    L = DEPTH
    s5_shape = (L, 2, S5_GROUPS, S5_STATE)
    n_idx = jnp.arange(S5_STATE, dtype=F32)
    ret_base = jnp.log(2.0 ** (5.0 + jnp.arange(RET_HEADS, dtype=F32)) - 1.0)
    return {
        "x": nrm(ks[0], (BATCH, SEQ, D_MODEL), 1.0),
        "c": nrm(ks[1], (BATCH, D_MODEL), 1.0),
        "ctx": nrm(ks[2], (BATCH, CTX_LEN, D_MODEL), 1.0),
        "c_ctx": nrm(ks[3], (D_MODEL,), 1.0),
        "ada_w": nrm(ks[4], (L, D_MODEL, N_MOD * D_MODEL), 0.5 * D_MODEL ** -0.5),
        "ada_b": nrm(ks[5], (L, N_MOD * D_MODEL), 0.02),
        "norm1_w": 1.0 + nrm(ks[6], (L, D_MODEL), 0.02),
        "norm2_w": 1.0 + nrm(ks[7], (L, D_MODEL), 0.02),
        "w_in": nrm(ks[8], (L, D_MODEL, PROJ_W), D_MODEL ** -0.5),
        "w_out": nrm(ks[9], (L, MIX_W, D_MODEL), MIX_W ** -0.5),
        "q_norm_w": 1.0 + nrm(ks[10], (L, HEAD_DIM), 0.02),
        "k_norm_w": 1.0 + nrm(ks[11], (L, HEAD_DIM), 0.02),
        "attn_sink": nrm(ks[12], (L, N_HEADS), 0.5),
        "s5_a_re": -0.5 + nrm(ks[13], s5_shape, 0.01),
        "s5_a_im": math.pi * n_idx + nrm(ks[14], s5_shape, 0.01),
        "s5_log_dt": jax.random.uniform(ks[15], s5_shape, F32, math.log(1e-3), math.log(1e-1)),
        "s5_b_re": nrm(ks[16], s5_shape + (S5_GROUP_CH,), (2 * S5_GROUP_CH) ** -0.5),
        "s5_b_im": nrm(ks[17], s5_shape + (S5_GROUP_CH,), (2 * S5_GROUP_CH) ** -0.5),
        "s5_c_re": nrm(ks[18], (L, 2, S5_GROUPS, S5_GROUP_CH, S5_STATE), 0.5),
        "s5_c_im": nrm(ks[19], (L, 2, S5_GROUPS, S5_GROUP_CH, S5_STATE), 0.5),
        "s5_d": nrm(ks[20], (L, S5_W), 0.5),
        "s5_glu_w": nrm(ks[21], (L, S5_W, S5_W), S5_W ** -0.5),
        "s5_glu_b": nrm(ks[22], (L, S5_W), 0.02),
        "ret_decay": ret_base + nrm(ks[23], (L, 2, RET_HEADS), 0.05),
        "peer_wq": nrm(ks[24], (L, D_MODEL, PEER_HEADS * PEER_QUERY_DIM), D_MODEL ** -0.5),
        "peer_keys": nrm(ks[25], (L, 2, PEER_HEADS, PEER_N_KEYS, PEER_HALF), PEER_HALF ** -0.5),
        "peer_u": nrm(ks[26], (L, PEER_EXPERTS, D_MODEL), D_MODEL ** -0.5),
        "peer_v": nrm(ks[27], (L, PEER_EXPERTS, D_MODEL), 1.0),
    }


def reference(x, c, ctx, c_ctx, ada_w, ada_b, norm1_w, norm2_w, w_in, w_out, q_norm_w, k_norm_w,
              attn_sink, s5_a_re, s5_a_im, s5_log_dt, s5_b_re, s5_b_im, s5_c_re, s5_c_im, s5_d,
              s5_glu_w, s5_glu_b, ret_decay, peer_wq, peer_keys, peer_u, peer_v):
    seq_len = x.shape[1]
    ROWS = seq_len // GRID_W
    att_cos, att_sin = axial_rope_tables(ROWS)
    ret_cos, ret_sin = flat_rope_tables(ROWS * GRID_W, RET_HEAD_DIM)
    for l in range(DEPTH):
        need_ctx = l < DEPTH - 1
        mod = adaln_params(c, ada_w[l], ada_b[l])
        mod_c = adaln_params(c_ctx, ada_w[l], ada_b[l])

        h = modulate(rms_norm(x, norm1_w[l]), mod[:, 0, None], mod[:, 1, None])
        hc = modulate(rms_norm(ctx, norm1_w[l]), mod_c[0], mod_c[1])
        aq, ak, av, su, rq, rk, rv, rg = split_projection(h @ w_in[l])
        caq, cak, cav, csu, crq, crk, crv, crg = split_projection(hc @ w_in[l])
        att, att_c = attention_group(aq, ak, av, caq, cak, cav, q_norm_w[l], k_norm_w[l], attn_sink[l],
                                     att_cos, att_sin, need_ctx)
        ssm, ssm_c = s5_group(su, csu, s5_a_re[l], s5_a_im[l], s5_log_dt[l], s5_b_re[l], s5_b_im[l],
                              s5_c_re[l], s5_c_im[l], s5_d[l], s5_glu_w[l], s5_glu_b[l], need_ctx)
        ret, ret_c = retention_group(rq, rk, rv, rg, crq, crk, crv, crg, ret_decay[l],
                                     ret_cos, ret_sin, need_ctx)
        x = x + mod[:, 2, None] * (jnp.concatenate([att, ssm, ret], axis=-1) @ w_out[l])

        h2 = modulate(rms_norm(x, norm2_w[l]), mod[:, 3, None], mod[:, 4, None])
        x = x + mod[:, 5, None] * peer_ffn(h2, peer_wq[l], peer_keys[l], peer_u[l], peer_v[l])

        if need_ctx:
            ctx = ctx + mod_c[2] * (jnp.concatenate([att_c, ssm_c, ret_c], axis=-1) @ w_out[l])
            hc2 = modulate(rms_norm(ctx, norm2_w[l]), mod_c[3], mod_c[4])
            ctx = ctx + mod_c[5] * peer_ffn(hc2, peer_wq[l], peer_keys[l], peer_u[l], peer_v[l])
    return x
```

```cpp
#ifndef CPU_EMU
#include <hip/hip_runtime.h>
#include <hip/hip_cooperative_groups.h>
#endif
#include <cstdio>
#include <cstdint>
#include <cmath>

#ifndef MEGA
#define MEGA 0
#endif

typedef unsigned short bf16_t;
typedef short bf16x8 __attribute__((ext_vector_type(8)));
typedef short bf16x4 __attribute__((ext_vector_type(4)));
typedef float f32x4 __attribute__((ext_vector_type(4)));
typedef unsigned long long u64;

constexpr int D = 1024, PROJ = 2048, NMOD = 6;
constexpr int NEXP = 16384;
constexpr int NTHREADS = 256;
constexpr int LDS_BYTES = 68608;
constexpr float EPS = 1e-6f;
constexpr int ZQ = 0, ZK = 512, ZV = 640, ZSU = 768, ZRQ = 1024, ZRK = 1280, ZRV = 1536, ZRG = 1792;

struct Params {
    const float *x, *c, *ctx, *c_ctx, *ada_w, *ada_b, *norm1_w, *norm2_w, *w_in, *w_out, *q_norm_w, *k_norm_w, *attn_sink,
        *s5_a_re, *s5_a_im, *s5_log_dt, *s5_b_re, *s5_b_im, *s5_c_re, *s5_c_im, *s5_d, *s5_glu_w, *s5_glu_b, *ret_decay,
        *peer_wq, *peer_keys, *peer_u, *peer_v;
    float* out;
    float *mod, *ropeA, *ropeR, *z, *ctxs, *s5_hend, *s5_hin, *ret_kv, *ret_sin, *pq, *gate;
    bf16_t *wt_in, *wt_out, *wt_pq, *wt_glu, *hb, *mix, *yg;
    int* eidx;
    int B, SEQ, CTX, NTOK, NCTX, NT, NLC, NCC;
};

__device__ __forceinline__ unsigned f2u(float f) { unsigned u; __builtin_memcpy(&u, &f, 4); return u; }
__device__ __forceinline__ float u2f(unsigned u) { float f; __builtin_memcpy(&f, &u, 4); return f; }
__device__ __forceinline__ bf16_t f2bf(float f) { unsigned u = f2u(f); u += 0x7fffu + ((u >> 16) & 1u); return (bf16_t)(u >> 16); }
__device__ __forceinline__ float bf2f(bf16_t h) { return u2f(((unsigned)h) << 16); }
__device__ __forceinline__ float gelu_tanh(float x) { const float k = 0.7978845608028654f; float t = k * (x + 0.044715f * x * x * x); float e = __expf(-2.f * t); return 0.5f * x * (1.f + (1.f - e) / (1.f + e)); }
__device__ __forceinline__ float sigmoidf_(float x) { return 1.f / (1.f + __expf(-x)); }
__device__ __forceinline__ float siluf_(float x) { return x / (1.f + __expf(-x)); }
__device__ __forceinline__ float wave_sum(float v) { for (int m = 32; m >= 1; m >>= 1) v += __shfl_xor(v, m); return v; }
__device__ __forceinline__ int mod_row(const Params& p, int r) { return r < p.NTOK ? r / p.SEQ : p.B; }
__device__ __forceinline__ const float* mod_ptr(const Params& p, int layer, int mrow, int which) { return p.mod + ((size_t)(layer * (p.B + 1) + mrow) * NMOD + which) * D; }
__device__ __forceinline__ const float* xsrc_row(const Params& p, int layer, int r) {
    if (layer == 0) return r < p.NTOK ? p.x + (size_t)r * D : p.ctx + (size_t)(r - p.NTOK) * D;
    return r < p.NTOK ? p.out + (size_t)r * D : p.ctxs + (size_t)(r - p.NTOK) * D;
}
__device__ __forceinline__ float* xdst_row(const Params& p, int r) { return r < p.NTOK ? p.out + (size_t)r * D : p.ctxs + (size_t)(r - p.NTOK) * D; }
__device__ __forceinline__ bool chunk_is_ctx(const Params& p, int gc) { return gc >= p.NTOK / 128; }
__device__ __forceinline__ int order_chunk(const Params& p, int b, int dir, int pos) {
    if (pos < p.NCC) { int j = dir ? (p.NCC - 1 - pos) : pos; return p.NTOK / 128 + b * p.NCC + j; }
    int j = pos - p.NCC; if (dir) j = p.NLC - 1 - j; return b * p.NLC + j;
}

__device__ void transpose_tile(const float* W, bf16_t* Wt, int K, int N, int tile, unsigned char* smem) {
    float* T = (float*)smem;
    const int tn = N / 64, tk0 = (tile / tn) * 64, tn0 = (tile % tn) * 64, tid = threadIdx.x;
    __syncthreads();
    for (int i = 0; i < 16; ++i) { int idx = tid + i * 256, kk = idx >> 6, nn = idx & 63; T[kk * 65 + nn] = W[(size_t)(tk0 + kk) * N + tn0 + nn]; }
    __syncthreads();
    for (int i = 0; i < 16; ++i) { int idx = tid + i * 256, nn = idx >> 6, kk = idx & 63; Wt[(size_t)(tn0 + nn) * K + tk0 + kk] = f2bf(T[kk * 65 + nn]); }
}
constexpr int T_IN = (D / 64) * (PROJ / 64), T_OUT = (D / 64) * (D / 64), T_PQ = T_OUT, T_GLU = 16;
constexpr int T_PER_LAYER = T_IN + T_OUT + T_PQ + T_GLU;
constexpr int MOD_ITEMS = 2 * (NMOD * D / 64);
__device__ void phase_prologue(const Params& p, int vb, unsigned char* smem) {
    const int tid = threadIdx.x;
    if (vb < 2 * T_PER_LAYER) {
        int l = vb / T_PER_LAYER, t = vb % T_PER_LAYER;
        if (t < T_IN) transpose_tile(p.w_in + (size_t)l * D * PROJ, p.wt_in + (size_t)l * D * PROJ, D, PROJ, t, smem);
        else if ((t -= T_IN) < T_OUT) transpose_tile(p.w_out + (size_t)l * D * D, p.wt_out + (size_t)l * D * D, D, D, t, smem);
        else if ((t -= T_OUT) < T_PQ) transpose_tile(p.peer_wq + (size_t)l * D * D, p.wt_pq + (size_t)l * D * D, D, D, t, smem);
        else { t -= T_PQ; transpose_tile(p.s5_glu_w + (size_t)l * 256 * 256, p.wt_glu + (size_t)l * 256 * 256, 256, 256, t, smem); }
        return;
    }
    vb -= 2 * T_PER_LAYER;
    if (vb < MOD_ITEMS) {
        const int l = vb / (NMOD * D / 64), col0 = (vb % (NMOD * D / 64)) * 64, nrow = p.B + 1;
        float* sc = (float*)smem;
        float* red = sc + 9 * 1024;
        __syncthreads();
        for (int i = tid; i < nrow * 1024; i += 256) { int r = i >> 10, k = i & 1023; float v = r < p.B ? p.c[r * 1024 + k] : p.c_ctx[k]; sc[i] = siluf_(v); }
        __syncthreads();
        const int cl = tid & 63, ks = tid >> 6;
        float acc[9]; for (int r = 0; r < 9; ++r) acc[r] = 0.f;
        const float* w = p.ada_w + (size_t)l * D * (NMOD * D) + col0 + cl;
        for (int k = ks * 256; k < ks * 256 + 256; ++k) { float wv = w[(size_t)k * (NMOD * D)];
#pragma unroll
            for (int r = 0; r < 9; ++r) acc[r] += sc[r * 1024 + k] * wv; }
#pragma unroll
        for (int r = 0; r < 9; ++r) red[(ks * 9 + r) * 64 + cl] = acc[r];
        __syncthreads();
        for (int i = tid; i < nrow * 64; i += 256) { int r = i >> 6, c2 = i & 63; float s = p.ada_b[l * NMOD * D + col0 + c2];
            for (int q = 0; q < 4; ++q) s += red[(q * 9 + r) * 64 + c2];
            p.mod[(size_t)(l * nrow + r) * NMOD * D + col0 + c2] = s; }
        return;
    }
    vb -= MOD_ITEMS;
    {
        int t = vb * 8 + (tid >> 5), i = tid & 31;
        if (t < p.SEQ) {
            float row = (float)(t / 64), col = (float)(t % 64);
            float inv = powf(10000.0f, -(float)(i & 15) / 16.0f);
            float ang = (i < 16 ? row : col) * inv;
            p.ropeA[(t * 32 + i) * 2] = cosf(ang); p.ropeA[(t * 32 + i) * 2 + 1] = sinf(ang);
            float inv2 = powf(10000.0f, -(float)i / 32.0f); float ang2 = (float)t * inv2;
            p.ropeR[(t * 32 + i) * 2] = cosf(ang2); p.ropeR[(t * 32 + i) * 2 + 1] = sinf(ang2);
        }
    }
}
__device__ __forceinline__ int prologue_items(const Params& p) { return 2 * T_PER_LAYER + MOD_ITEMS + (p.SEQ + 7) / 8; }

template <int WHICH  >
__device__ void phase_norm(const Params& p, int layer, int vb, int nrows) {
    const int lane = threadIdx.x & 63, r = vb * 4 + (threadIdx.x >> 6);
    if (r >= nrows) return;
    const float* src = (WHICH == 0) ? xsrc_row(p, layer, r) : xdst_row(p, r);
    const float* nw = (WHICH == 0 ? p.norm1_w : p.norm2_w) + layer * D;
    const int mr = mod_row(p, r);
    const float* sh = mod_ptr(p, layer, mr, WHICH ? 3 : 0); const float* sc = mod_ptr(p, layer, mr, WHICH ? 4 : 1);
    f32x4 v[4]; float ss = 0.f;
#pragma unroll
    for (int i = 0; i < 4; ++i) { v[i] = *(const f32x4*)(src + i * 256 + lane * 4); ss += v[i][0] * v[i][0] + v[i][1] * v[i][1] + v[i][2] * v[i][2] + v[i][3] * v[i][3]; }
    ss = wave_sum(ss);
    const float rstd = rsqrtf(ss * (1.0f / D) + EPS);
#pragma unroll
    for (int i = 0; i < 4; ++i) { const int c0 = i * 256 + lane * 4; bf16x4 o;
#pragma unroll
        for (int j = 0; j < 4; ++j) { float y = v[i][j] * rstd * nw[c0 + j]; y = y * (1.f + sc[c0 + j]) + sh[c0 + j]; o[j] = (short)f2bf(y); }
        *(bf16x4*)(p.hb + (size_t)r * D + c0) = o; }
}

constexpr int GLD = 72;
template <class Epi>
__device__ void gemm_tile(const bf16_t* A, int lda, const bf16_t* Bt, int ldb, int K, int m0, int n0, unsigned char* smem, const Epi& epi) {
    bf16_t* As = (bf16_t*)smem; bf16_t* Bs = As + 128 * GLD;
    const int tid = threadIdx.x, lane = tid & 63, wid = tid >> 6, wr = wid >> 1, wc = wid & 1, fr = lane & 15, fq = lane >> 4;
    f32x4 acc[4][4];
#pragma unroll
    for (int i = 0; i < 4; ++i)
#pragma unroll
        for (int j = 0; j < 4; ++j) acc[i][j] = (f32x4){0.f, 0.f, 0.f, 0.f};
    for (int k0 = 0; k0 < K; k0 += 64) {
        __syncthreads();
#pragma unroll
        for (int i = 0; i < 4; ++i) { const int ch = tid + i * 256, row = ch >> 3, cc = ch & 7;
            *(bf16x8*)(As + row * GLD + cc * 8) = *(const bf16x8*)(A + (size_t)(m0 + row) * lda + k0 + cc * 8);
            *(bf16x8*)(Bs + row * GLD + cc * 8) = *(const bf16x8*)(Bt + (size_t)(n0 + row) * ldb + k0 + cc * 8); }
        __syncthreads();
#pragma unroll
        for (int kk = 0; kk < 2; ++kk) {
            bf16x8 a[4], b[4];
#pragma unroll
            for (int i = 0; i < 4; ++i) { a[i] = *(const bf16x8*)(As + (wr * 64 + i * 16 + fr) * GLD + kk * 32 + fq * 8); b[i] = *(const bf16x8*)(Bs + (wc * 64 + i * 16 + fr) * GLD + kk * 32 + fq * 8); }
#pragma unroll
            for (int i = 0; i < 4; ++i)
#pragma unroll
                for (int j = 0; j < 4; ++j) acc[i][j] = __builtin_amdgcn_mfma_f32_16x16x32_bf16(a[i], b[j], acc[i][j], 0, 0, 0);
        }
    }
#pragma unroll
    for (int i = 0; i < 4; ++i)
#pragma unroll
        for (int j = 0; j < 4; ++j)
#pragma unroll
            for (int r = 0; r < 4; ++r) epi(m0 + wr * 64 + i * 16 + fq * 4 + r, n0 + wc * 64 + j * 16 + fr, acc[i][j][r]);
}
struct EpiStoreF32 { float* C; int ldc; __device__ __forceinline__ void operator()(int r, int c, float v) const { C[(size_t)r * ldc + c] = v; } };
struct EpiResidual {
    const float *src_lat, *src_ctx, *gate; float *dst_lat, *dst_ctx; int NTOK, SEQ, B;
    __device__ __forceinline__ void operator()(int r, int c, float v) const {
        if (r < NTOK) { const float g = gate[(size_t)(r / SEQ) * NMOD * D + c]; dst_lat[(size_t)r * D + c] = src_lat[(size_t)r * D + c] + g * v; }
        else { const float g = gate[(size_t)B * NMOD * D + c]; const size_t o = (size_t)(r - NTOK) * D + c; dst_ctx[o] = src_ctx[o] + g * v; } } };
__device__ __forceinline__ EpiResidual make_epi_residual(const Params& p, int layer) {
    EpiResidual e; e.src_lat = layer == 0 ? p.x : p.out; e.src_ctx = layer == 0 ? p.ctx : p.ctxs; e.dst_lat = p.out; e.dst_ctx = p.ctxs;
    e.gate = p.mod + ((size_t)(layer * (p.B + 1)) * NMOD + 2) * D; e.NTOK = p.NTOK; e.SEQ = p.SEQ; e.B = p.B; return e; }
struct EpiGlu {
    const bf16_t* yg; bf16_t* mix; const float* bias;
    __device__ __forceinline__ void operator()(int r, int c, float v) const { float y = bf2f(yg[(size_t)r * 256 + c]); mix[(size_t)r * D + 512 + c] = f2bf(y * sigmoidf_(v + bias[c])); } };

__device__ void phase_post(const Params& p, int layer, int vb) {
    const int lane = threadIdx.x & 63, r = vb * 4 + (threadIdx.x >> 6);
    if (r >= p.NT) return;
    float* z = p.z + (size_t)r * PROJ;
    const bool lat = r < p.NTOK; const int t = lat ? r % p.SEQ : 0;
    const int i = lane & 31, hh = lane >> 5;
    const float* qw = p.q_norm_w + layer * 64; const float* kw = p.k_norm_w + layer * 64;
    float ca = 1.f, sa = 0.f, cr = 1.f, sr = 0.f;
    if (lat) { ca = p.ropeA[(t * 32 + i) * 2]; sa = p.ropeA[(t * 32 + i) * 2 + 1]; cr = p.ropeR[(t * 32 + i) * 2]; sr = p.ropeR[(t * 32 + i) * 2 + 1]; }
#pragma unroll
    for (int hp = 0; hp < 5; ++hp) {
        const int base = (hp < 4) ? ZQ + (hp * 2 + hh) * 64 : ZK + hh * 64; const float* w = hp < 4 ? qw : kw;
        float x1 = z[base + i], x2 = z[base + 32 + i]; float ss = x1 * x1 + x2 * x2;
        for (int m = 16; m >= 1; m >>= 1) ss += __shfl_xor(ss, m);
        const float rstd = rsqrtf(ss * (1.f / 64.f) + EPS);
        float y1 = x1 * rstd * w[i], y2 = x2 * rstd * w[32 + i];
        float o1 = y1 * ca - y2 * sa, o2 = y1 * sa + y2 * ca;
        const float s = hp < 4 ? 0.125f : 1.f;
        z[base + i] = o1 * s; z[base + 32 + i] = o2 * s;
    }
#pragma unroll
    for (int hp = 0; hp < 4; ++hp) {
        const int base = (hp < 2 ? ZRQ + (hp * 2 + hh) * 64 : ZRK + ((hp - 2) * 2 + hh) * 64);
        float x1 = z[base + i], x2 = z[base + 32 + i];
        float o1 = x1 * cr - x2 * sr, o2 = x1 * sr + x2 * cr; const float s = hp < 2 ? 0.125f : 1.f;
        z[base + i] = o1 * s; z[base + 32 + i] = o2 * s;
    }
}

constexpr int KLD = 72, VLD = 136;
__device__ void attn_item(const Params& p, int layer, int qrow0, int b, int qb  , int h, unsigned char* smem) {
    bf16_t* Ks = (bf16_t*)smem; bf16_t* Vt = Ks + 128 * KLD;
    const int tid = threadIdx.x, lane = tid & 63, w = tid >> 6, fr = lane & 15, fq = lane >> 4, hkv = h >> 2;
    bf16x8 qf[2][2];
#pragma unroll
    for (int nt = 0; nt < 2; ++nt)
#pragma unroll
        for (int ks = 0; ks < 2; ++ks) { const float* q = p.z + (size_t)(qrow0 + w * 32 + nt * 16 + fr) * PROJ + ZQ + h * 64 + ks * 32 + fq * 8;
            f32x4 a = *(const f32x4*)q, c = *(const f32x4*)(q + 4);
            qf[nt][ks] = (bf16x8){(short)f2bf(a[0]), (short)f2bf(a[1]), (short)f2bf(a[2]), (short)f2bf(a[3]), (short)f2bf(c[0]), (short)f2bf(c[1]), (short)f2bf(c[2]), (short)f2bf(c[3])}; }
    const float sink = p.attn_sink[layer * 8 + h];
    float m_[2] = {sink, sink}, l_[2] = {0.f, 0.f};
    f32x4 o[4][2];
#pragma unroll
    for (int i = 0; i < 4; ++i) { o[i][0] = (f32x4){0.f, 0.f, 0.f, 0.f}; o[i][1] = o[i][0]; }
    const int ntile = p.NCC + (qb < 0 ? 0 : 3);
    for (int ti = 0; ti < ntile; ++ti) {
        int krow0, mask = 0;
        if (ti < p.NCC) krow0 = p.NTOK + b * p.CTX + ti * 128;
        else { const int kb = qb + (ti - p.NCC) - 1; if (kb < 0 || kb >= p.NLC) continue; krow0 = b * p.SEQ + kb * 128; mask = (kb < qb) ? 1 : (kb > qb ? 2 : 0); }
        __syncthreads();
#pragma unroll
        for (int i = 0; i < 8; ++i) { const int idx = tid + i * 256, key = idx >> 4, d4 = idx & 15; const float* src = p.z + (size_t)(krow0 + key) * PROJ + hkv * 64 + d4 * 4;
            f32x4 kv = *(const f32x4*)(src + ZK), vv = *(const f32x4*)(src + ZV);
            *(bf16x4*)(Ks + key * KLD + d4 * 4) = (bf16x4){(short)f2bf(kv[0]), (short)f2bf(kv[1]), (short)f2bf(kv[2]), (short)f2bf(kv[3])};
#pragma unroll
            for (int c = 0; c < 4; ++c) Vt[(d4 * 4 + c) * VLD + key] = f2bf(vv[c]); }
        __syncthreads();
        f32x4 s[8][2];
#pragma unroll
        for (int mt = 0; mt < 8; ++mt) { s[mt][0] = (f32x4){0.f, 0.f, 0.f, 0.f}; s[mt][1] = s[mt][0];
#pragma unroll
            for (int ks = 0; ks < 2; ++ks) { bf16x8 a = *(const bf16x8*)(Ks + (mt * 16 + fr) * KLD + ks * 32 + fq * 8);
                s[mt][0] = __builtin_amdgcn_mfma_f32_16x16x32_bf16(a, qf[0][ks], s[mt][0], 0, 0, 0);
                s[mt][1] = __builtin_amdgcn_mfma_f32_16x16x32_bf16(a, qf[1][ks], s[mt][1], 0, 0, 0); } }
#pragma unroll
        for (int nt = 0; nt < 2; ++nt) {
            const int qq = w * 32 + nt * 16 + fr; float mx = -3.0e38f;
#pragma unroll
            for (int mt = 0; mt < 8; ++mt)
#pragma unroll
                for (int r = 0; r < 4; ++r) { const int kk = mt * 16 + fq * 4 + r; bool ok = mask == 0 || (mask == 1 ? kk >= qq : kk <= qq); float v = ok ? s[mt][nt][r] : -3.0e38f; s[mt][nt][r] = v; mx = fmaxf(mx, v); }
            mx = fmaxf(mx, __shfl_xor(mx, 16)); mx = fmaxf(mx, __shfl_xor(mx, 32));
            const float mn = fmaxf(m_[nt], mx), alpha = __expf(m_[nt] - mn); m_[nt] = mn; float ls = 0.f;
#pragma unroll
            for (int mt = 0; mt < 8; ++mt)
#pragma unroll
                for (int r = 0; r < 4; ++r) { float e = __expf(s[mt][nt][r] - mn); s[mt][nt][r] = e; ls += e; }
            l_[nt] = l_[nt] * alpha + ls;
#pragma unroll
            for (int dt = 0; dt < 4; ++dt) o[dt][nt] *= alpha;
        }
#pragma unroll
        for (int ks2 = 0; ks2 < 4; ++ks2) {
            bf16x8 pb[2];
#pragma unroll
            for (int nt = 0; nt < 2; ++nt)
#pragma unroll
                for (int j = 0; j < 8; ++j) pb[nt][j] = (short)f2bf(s[2 * ks2 + (j >> 2)][nt][j & 3]);
#pragma unroll
            for (int dt = 0; dt < 4; ++dt) { const bf16_t* vp = Vt + (dt * 16 + fr) * VLD + fq * 4;
                bf16x4 v0 = *(const bf16x4*)(vp + (2 * ks2) * 16), v1 = *(const bf16x4*)(vp + (2 * ks2 + 1) * 16);
                bf16x8 a = (bf16x8){v0[0], v0[1], v0[2], v0[3], v1[0], v1[1], v1[2], v1[3]};
                o[dt][0] = __builtin_amdgcn_mfma_f32_16x16x32_bf16(a, pb[0], o[dt][0], 0, 0, 0);
                o[dt][1] = __builtin_amdgcn_mfma_f32_16x16x32_bf16(a, pb[1], o[dt][1], 0, 0, 0); }
        }
    }
#pragma unroll
    for (int nt = 0; nt < 2; ++nt) {
        float l = l_[nt]; l += __shfl_xor(l, 16); l += __shfl_xor(l, 32); l += __expf(sink - m_[nt]);
        const float inv = 1.f / l; const int row = qrow0 + w * 32 + nt * 16 + fr;
#pragma unroll
        for (int dt = 0; dt < 4; ++dt) { bf16x4 ov;
#pragma unroll
            for (int r = 0; r < 4; ++r) ov[r] = (short)f2bf(o[dt][nt][r] * inv);
            *(bf16x4*)(p.mix + (size_t)row * D + h * 64 + dt * 16 + fq * 4) = ov; }
    }
}

struct cplx { float re, im; };
__device__ __forceinline__ cplx cmul(cplx a, cplx b) { return {a.re * b.re - a.im * b.im, a.re * b.im + a.im * b.re}; }
__device__ __forceinline__ void s5_disc(const Params& p, int layer, int dir, int g, int pp, float pw, cplx& abar, cplx& coef) {
    const int idx = ((layer * 2 + dir) * 16 + g) * 64 + pp;
    const float are = p.s5_a_re[idx], aim = p.s5_a_im[idx], dt = expf(p.s5_log_dt[idx]);
    const float mg = expf(are * dt); abar = {mg * cosf(aim * dt), mg * sinf(aim * dt)};
    const float den = 1.f / (are * are + aim * aim); const float nr = abar.re - 1.f, ni = abar.im;
    coef = {(nr * are + ni * aim) * den, (ni * are - nr * aim) * den};
    if (pw != 1.f) { const float mgp = expf(are * dt * pw); abar = {mgp * cosf(aim * dt * pw), mgp * sinf(aim * dt * pw)}; }
}
__device__ void s5_phaseA(const Params& p, int layer, int vb) {
    const int lane = threadIdx.x & 63, w = threadIdx.x >> 6;
    const int dir = vb & 1, gq = (vb >> 1) & 3, gc = vb >> 3, g = gq * 4 + w;
    cplx ab, cf; s5_disc(p, layer, dir, g, lane, 1.f, ab, cf);
    float bre[16], bim[16];
    { const int bi = (((layer * 2 + dir) * 16 + g) * 64 + lane) * 16;
#pragma unroll
      for (int h = 0; h < 16; ++h) { cplx bb = cmul(cf, (cplx){p.s5_b_re[bi + h], p.s5_b_im[bi + h]}); bre[h] = bb.re; bim[h] = bb.im; } }
    cplx hs = {0.f, 0.f};
    for (int t = 0; t < 128; ++t) {
        const int tt = dir ? 127 - t : t; const float* u = p.z + (size_t)(gc * 128 + tt) * PROJ + ZSU + g * 16;
        float br = 0.f, bi2 = 0.f;
#pragma unroll
        for (int h = 0; h < 16; ++h) { const float uv = u[h]; br += bre[h] * uv; bi2 += bim[h] * uv; }
        cplx nh = cmul(ab, hs); hs = {nh.re + br, nh.im + bi2};
    }
    float* dst = p.s5_hend + ((((size_t)gc * 2 + dir) * 16 + g) * 64 + lane) * 2; dst[0] = hs.re; dst[1] = hs.im;
}
__device__ void s5_phaseB(const Params& p, int layer, int vb) {
    const int idx = vb * 256 + threadIdx.x; if (idx >= p.B * 2 * 16 * 64) return;
    const int pp = idx & 63, g = (idx >> 6) & 15, dir = (idx >> 10) & 1, b = idx >> 11;
    cplx a128, cf; s5_disc(p, layer, dir, g, pp, 128.f, a128, cf);
    cplx H = {0.f, 0.f};
    for (int pos = 0; pos < p.NCC + p.NLC; ++pos) {
        const int gc = order_chunk(p, b, dir, pos); const size_t o = ((((size_t)gc * 2 + dir) * 16 + g) * 64 + pp) * 2;
        p.s5_hin[o] = H.re; p.s5_hin[o + 1] = H.im;
        cplx nh = cmul(a128, H); H = {nh.re + p.s5_hend[o], nh.im + p.s5_hend[o + 1]};
    }
}
constexpr int S5_HT = 16 * 65 * 2;
__device__ void s5_phaseC(const Params& p, int layer, int vb, unsigned char* smem) {
    const int lane = threadIdx.x & 63, w = threadIdx.x >> 6, gq = vb & 3, gc = vb >> 2, g = gq * 4 + w;
    float* ht = (float*)smem + w * (S5_HT + 2048); float* cm = ht + S5_HT;
    const int tt = lane & 15, hq = lane >> 4;
    float y[8][4];
#pragma unroll
    for (int s = 0; s < 8; ++s)
#pragma unroll
        for (int c = 0; c < 4; ++c) y[s][c] = 0.f;
    __syncthreads();
#pragma unroll
    for (int dir = 0; dir < 2; ++dir) {
        cplx ab, cf; s5_disc(p, layer, dir, g, lane, 1.f, ab, cf);
        float bre[16], bim[16];
        { const int bi = (((layer * 2 + dir) * 16 + g) * 64 + lane) * 16;
#pragma unroll
          for (int h = 0; h < 16; ++h) { cplx bb = cmul(cf, (cplx){p.s5_b_re[bi + h], p.s5_b_im[bi + h]}); bre[h] = bb.re; bim[h] = bb.im; } }
        { const int ci = ((layer * 2 + dir) * 16 + g) * 16 * 64;
          for (int i = lane; i < 1024; i += 64) { cm[i * 2] = p.s5_c_re[ci + i]; cm[i * 2 + 1] = p.s5_c_im[ci + i]; } }
        const size_t ho = ((((size_t)gc * 2 + dir) * 16 + g) * 64 + lane) * 2;
        cplx hs = {p.s5_hin[ho], p.s5_hin[ho + 1]};
#pragma unroll
        for (int s = 0; s < 8; ++s) {
            const int sub = dir ? 7 - s : s;
#pragma unroll 1
            for (int t = 0; t < 16; ++t) {
                const int tl = dir ? 15 - t : t; const float* u = p.z + (size_t)(gc * 128 + sub * 16 + tl) * PROJ + ZSU + g * 16;
                float br = 0.f, bi2 = 0.f;
#pragma unroll
                for (int h = 0; h < 16; ++h) { const float uv = u[h]; br += bre[h] * uv; bi2 += bim[h] * uv; }
                cplx nh = cmul(ab, hs); hs = {nh.re + br, nh.im + bi2};
                ht[(tl * 65 + lane) * 2] = hs.re; ht[(tl * 65 + lane) * 2 + 1] = hs.im;
            }
#ifndef CPU_EMU
            __builtin_amdgcn_s_waitcnt(0xc07f); __builtin_amdgcn_wave_barrier();
#else
            emu::wave_sync();
#endif
            float a0 = 0.f, a1 = 0.f, a2 = 0.f, a3 = 0.f;
#pragma unroll 4
            for (int pp = 0; pp < 64; ++pp) { const float hr = ht[(tt * 65 + pp) * 2], hi = ht[(tt * 65 + pp) * 2 + 1]; const float* c4 = cm + ((hq * 4) * 64 + pp) * 2;
                a0 += c4[0] * hr - c4[1] * hi; a1 += c4[128] * hr - c4[129] * hi; a2 += c4[256] * hr - c4[257] * hi; a3 += c4[384] * hr - c4[385] * hi; }
            y[sub][0] += a0; y[sub][1] += a1; y[sub][2] += a2; y[sub][3] += a3;
#ifndef CPU_EMU
            __builtin_amdgcn_s_waitcnt(0xc07f); __builtin_amdgcn_wave_barrier();
#else
            emu::wave_sync();
#endif
        }
    }
#pragma unroll
    for (int s = 0; s < 8; ++s) { const int row = gc * 128 + s * 16 + tt; const float* u = p.z + (size_t)row * PROJ + ZSU + g * 16 + hq * 4; bf16x4 ov;
#pragma unroll
        for (int c = 0; c < 4; ++c) { float v = y[s][c] + p.s5_d[layer * 256 + g * 16 + hq * 4 + c] * u[c]; ov[c] = (short)f2bf(gelu_tanh(v)); }
        *(bf16x4*)(p.yg + (size_t)row * 256 + g * 16 + hq * 4) = ov; }
}

__device__ __forceinline__ float ret_loggamma(const Params& p, int layer, int dir, int h) { const float x = p.ret_decay[(layer * 2 + dir) * 4 + h]; return -log1pf(expf(-x)); }
__device__ void ret_phaseA(const Params& p, int layer, int vb, unsigned char* smem) {
    const int tid = threadIdx.x, h = vb & 3, gc = vb >> 2;
    float* Ks = (float*)smem; float* Vs = Ks + 128 * 64;
    __syncthreads();
    for (int i = 0; i < 8; ++i) { const int idx = tid + i * 256, m = idx >> 4, d4 = idx & 15; const float* src = p.z + (size_t)(gc * 128 + m) * PROJ + h * 64 + d4 * 4;
        *(f32x4*)(Ks + m * 64 + d4 * 4) = *(const f32x4*)(src + ZRK); *(f32x4*)(Vs + m * 64 + d4 * 4) = *(const f32x4*)(src + ZRV); }
    __syncthreads();
    const float lgf = ret_loggamma(p, layer, 0, h), lgb = ret_loggamma(p, layer, 1, h);
    const int e = tid & 63, dg = tid >> 6;
    float af[16], ab[16];
#pragma unroll
    for (int i = 0; i < 16; ++i) { af[i] = 0.f; ab[i] = 0.f; }
    for (int m = 0; m < 128; ++m) { const float v = Vs[m * 64 + e], vf = v * __expf(lgf * (127 - m)), vb2 = v * __expf(lgb * m);
#pragma unroll
        for (int i = 0; i < 16; ++i) { const float k = Ks[m * 64 + dg * 16 + i]; af[i] += k * vf; ab[i] += k * vb2; } }
    float* of = p.ret_kv + (((size_t)gc * 4 + h) * 2 + 0) * 4096 + e * 64 + dg * 16; float* ob = of + 4096;
#pragma unroll
    for (int i = 0; i < 16; ++i) { of[i] = af[i]; ob[i] = ab[i]; }
}
__device__ void ret_phaseB(const Params& p, int layer, int vb) {
    const int id = vb * 256 + threadIdx.x; if (id >= p.B * 4 * 2 * 4096) return;
    const int i = id & 4095, dir = (id >> 12) & 1, h = (id >> 13) & 3, b = id >> 15;
    const float g128 = expf(128.f * ret_loggamma(p, layer, dir, h)); float S = 0.f;
    for (int pos = 0; pos < p.NCC + p.NLC; ++pos) { const int gc = order_chunk(p, b, dir, pos); const size_t o = (((size_t)gc * 4 + h) * 2 + dir) * 4096 + i;
        p.ret_sin[o] = S; S = g128 * S + p.ret_kv[o]; }
}
__device__ void ret_phaseC(const Params& p, int layer, int vb, unsigned char* smem) {
    const int tid = threadIdx.x, lane = tid & 63, w = tid >> 6, fr = lane & 15, fq = lane >> 4, h = vb & 3, gc = vb >> 2;
    bf16_t* Ks = (bf16_t*)smem; bf16_t* Vt = Ks + 128 * KLD; bf16_t* Sf = Vt + 64 * VLD; bf16_t* Sb = Sf + 64 * KLD;
    const float lgf = ret_loggamma(p, layer, 0, h), lgb = ret_loggamma(p, layer, 1, h);
    const int row0 = gc * 128;
    __syncthreads();
#pragma unroll
    for (int i = 0; i < 8; ++i) { const int idx = tid + i * 256, key = idx >> 4, d4 = idx & 15; const float* src = p.z + (size_t)(row0 + key) * PROJ + h * 64 + d4 * 4;
        f32x4 kv = *(const f32x4*)(src + ZRK), vv = *(const f32x4*)(src + ZRV);
        *(bf16x4*)(Ks + key * KLD + d4 * 4) = (bf16x4){(short)f2bf(kv[0]), (short)f2bf(kv[1]), (short)f2bf(kv[2]), (short)f2bf(kv[3])};
#pragma unroll
        for (int c = 0; c < 4; ++c) Vt[(d4 * 4 + c) * VLD + key] = f2bf(vv[c]); }
    { const float* sf = p.ret_sin + (((size_t)gc * 4 + h) * 2) * 4096;
#pragma unroll
      for (int i = 0; i < 8; ++i) { const int idx = tid + i * 256, which = idx >> 10, e = (idx >> 4) & 63, d4 = idx & 15; f32x4 v = *(const f32x4*)(sf + which * 4096 + e * 64 + d4 * 4);
          *(bf16x4*)((which ? Sb : Sf) + e * KLD + d4 * 4) = (bf16x4){(short)f2bf(v[0]), (short)f2bf(v[1]), (short)f2bf(v[2]), (short)f2bf(v[3])}; } }
    __syncthreads();
    bf16x8 qf[2][2], qff[2][2], qfb[2][2];
#pragma unroll
    for (int nt = 0; nt < 2; ++nt) { const int c = w * 32 + nt * 16 + fr; const float wf = __expf(lgf * (c + 1)), wb = __expf(lgb * (128 - c));
#pragma unroll
        for (int ks = 0; ks < 2; ++ks) { const float* q = p.z + (size_t)(row0 + c) * PROJ + ZRQ + h * 64 + ks * 32 + fq * 8;
#pragma unroll
            for (int j = 0; j < 8; ++j) { const float v = q[j]; qf[nt][ks][j] = (short)f2bf(v); qff[nt][ks][j] = (short)f2bf(v * wf); qfb[nt][ks][j] = (short)f2bf(v * wb); } } }
    f32x4 o[4][2];
#pragma unroll
    for (int i = 0; i < 4; ++i) { o[i][0] = (f32x4){0.f, 0.f, 0.f, 0.f}; o[i][1] = o[i][0]; }
#pragma unroll
    for (int dt = 0; dt < 4; ++dt)
#pragma unroll
        for (int ks = 0; ks < 2; ++ks) { bf16x8 af = *(const bf16x8*)(Sf + (dt * 16 + fr) * KLD + ks * 32 + fq * 8), ab = *(const bf16x8*)(Sb + (dt * 16 + fr) * KLD + ks * 32 + fq * 8);
#pragma unroll
            for (int nt = 0; nt < 2; ++nt) { o[dt][nt] = __builtin_amdgcn_mfma_f32_16x16x32_bf16(af, qff[nt][ks], o[dt][nt], 0, 0, 0); o[dt][nt] = __builtin_amdgcn_mfma_f32_16x16x32_bf16(ab, qfb[nt][ks], o[dt][nt], 0, 0, 0); } }
    f32x4 s[8][2];
#pragma unroll
    for (int mt = 0; mt < 8; ++mt) { s[mt][0] = (f32x4){0.f, 0.f, 0.f, 0.f}; s[mt][1] = s[mt][0];
#pragma unroll
        for (int ks = 0; ks < 2; ++ks) { bf16x8 a = *(const bf16x8*)(Ks + (mt * 16 + fr) * KLD + ks * 32 + fq * 8);
            s[mt][0] = __builtin_amdgcn_mfma_f32_16x16x32_bf16(a, qf[0][ks], s[mt][0], 0, 0, 0);
            s[mt][1] = __builtin_amdgcn_mfma_f32_16x16x32_bf16(a, qf[1][ks], s[mt][1], 0, 0, 0); } }
#pragma unroll
    for (int nt = 0; nt < 2; ++nt) { const int c = w * 32 + nt * 16 + fr;
#pragma unroll
        for (int mt = 0; mt < 8; ++mt)
#pragma unroll
            for (int r = 0; r < 4; ++r) { const int m = mt * 16 + fq * 4 + r; const float dd = c > m ? __expf(lgf * (c - m)) : (m > c ? __expf(lgb * (m - c)) : 2.f); s[mt][nt][r] *= dd; } }
#pragma unroll
    for (int ks2 = 0; ks2 < 4; ++ks2) {
        bf16x8 pb[2];
#pragma unroll
        for (int nt = 0; nt < 2; ++nt)
#pragma unroll
            for (int j = 0; j < 8; ++j) pb[nt][j] = (short)f2bf(s[2 * ks2 + (j >> 2)][nt][j & 3]);
#pragma unroll
        for (int dt = 0; dt < 4; ++dt) { const bf16_t* vp = Vt + (dt * 16 + fr) * VLD + fq * 4;
            bf16x4 v0 = *(const bf16x4*)(vp + (2 * ks2) * 16), v1 = *(const bf16x4*)(vp + (2 * ks2 + 1) * 16);
            bf16x8 a = (bf16x8){v0[0], v0[1], v0[2], v0[3], v1[0], v1[1], v1[2], v1[3]};
            o[dt][0] = __builtin_amdgcn_mfma_f32_16x16x32_bf16(a, pb[0], o[dt][0], 0, 0, 0);
            o[dt][1] = __builtin_amdgcn_mfma_f32_16x16x32_bf16(a, pb[1], o[dt][1], 0, 0, 0); }
    }
#pragma unroll
    for (int nt = 0; nt < 2; ++nt) { float ss = 0.f;
#pragma unroll
        for (int dt = 0; dt < 4; ++dt)
#pragma unroll
            for (int r = 0; r < 4; ++r) ss += o[dt][nt][r] * o[dt][nt][r];
        ss += __shfl_xor(ss, 16); ss += __shfl_xor(ss, 32);
        const float rstd = rsqrtf(ss * (1.f / 64.f) + EPS); const int row = row0 + w * 32 + nt * 16 + fr;
#pragma unroll
        for (int dt = 0; dt < 4; ++dt) { const int e0 = dt * 16 + fq * 4; f32x4 gv = *(const f32x4*)(p.z + (size_t)row * PROJ + ZRG + h * 64 + e0); bf16x4 ov;
#pragma unroll
            for (int r = 0; r < 4; ++r) ov[r] = (short)f2bf(o[dt][nt][r] * rstd * siluf_(gv[r]));
            *(bf16x4*)(p.mix + (size_t)row * D + 768 + h * 64 + e0) = ov; }
    }
}

__device__ __forceinline__ u64 pack_key(float v, unsigned idx) { unsigned u = f2u(v); u ^= (u >> 31) ? 0xffffffffu : 0x80000000u; return ((u64)u << 32) | (u64)(0xffffffffu - idx); }
__device__ __forceinline__ float unpack_val(u64 k) { unsigned u = (unsigned)(k >> 32); u ^= (u >> 31) ? 0x80000000u : 0xffffffffu; return u2f(u); }
__device__ __forceinline__ unsigned unpack_idx(u64 k) { return 0xffffffffu - (unsigned)k; }
__device__ __forceinline__ u64 wave_max_u64(u64 v) { for (int m = 32; m >= 1; m >>= 1) { u64 o = __shfl_xor(v, m); v = o > v ? o : v; } return v; }
__device__ void peer_score(const Params& p, int layer, int vb, unsigned char* smem) {
    const int lane = threadIdx.x & 63, w = threadIdx.x >> 6, r = vb >> 1, h = (vb & 1) * 4 + w;
    float* ql = (float*)smem + w * 256;
    float* tv = ql + 128; int* ti = (int*)(tv + 32);
    __syncthreads();
    const float* q = p.pq + (size_t)r * D + h * 128;
    ql[lane] = q[lane]; ql[lane + 64] = q[lane + 64];
    __syncthreads();
    u64 best[2][2];
#pragma unroll
    for (int half = 0; half < 2; ++half)
#pragma unroll
        for (int kk = 0; kk < 2; ++kk) { const int k = lane + kk * 64; const float* kp = p.peer_keys + ((((size_t)layer * 2 + half) * 8 + h) * 128 + k) * 64; float s = 0.f;
            for (int d4 = 0; d4 < 16; ++d4) { f32x4 kv = *(const f32x4*)(kp + d4 * 4); const float* qq = ql + half * 64 + d4 * 4; s += kv[0] * qq[0] + kv[1] * qq[1] + kv[2] * qq[2] + kv[3] * qq[3]; }
            best[half][kk] = pack_key(s, (unsigned)k); }
#pragma unroll
    for (int half = 0; half < 2; ++half)
        for (int it = 0; it < 16; ++it) { u64 m = best[half][0] > best[half][1] ? best[half][0] : best[half][1]; m = wave_max_u64(m);
            if (best[half][0] == m) best[half][0] = 0; if (best[half][1] == m) best[half][1] = 0;
            if (lane == 0) { tv[half * 16 + it] = unpack_val(m); ti[half * 16 + it] = (int)unpack_idx(m); } }
    __syncthreads();
    u64 cand[4]; const int ci = lane >> 2;
#pragma unroll
    for (int rr = 0; rr < 4; ++rr) { const int j = (lane & 3) * 4 + rr; cand[rr] = pack_key(tv[ci] + tv[16 + j], (unsigned)(lane * 4 + rr)); }
    float bv = 0.f; int be = 0;
    for (int it = 0; it < 16; ++it) { u64 m = cand[0]; m = cand[1] > m ? cand[1] : m; m = cand[2] > m ? cand[2] : m; m = cand[3] > m ? cand[3] : m; m = wave_max_u64(m);
#pragma unroll
        for (int rr = 0; rr < 4; ++rr) if (cand[rr] == m) cand[rr] = 0;
        if (lane == it) { const unsigned c = unpack_idx(m); bv = unpack_val(m); be = ti[c >> 4] * 128 + ti[16 + (c & 15)]; } }
    const float mx = __shfl(bv, 0); float e = lane < 16 ? __expf(bv - mx) : 0.f; float s = e;
    for (int m = 8; m >= 1; m >>= 1) s += __shfl_xor(s, m);
    if (lane < 16) { p.gate[(size_t)r * 128 + h * 16 + lane] = e / s; p.eidx[(size_t)r * 128 + h * 16 + lane] = be; }
}
__device__ void peer_gather(const Params& p, int layer, int vb, unsigned char* smem) {
    const int tid = threadIdx.x, lane = tid & 63, w = tid >> 6, r = vb;
    float* wl = (float*)smem; int* el = (int*)(wl + 128);
    __syncthreads();
    if (tid < 128) el[tid] = p.eidx[(size_t)r * 128 + tid];
    float hv[16];
#pragma unroll
    for (int i = 0; i < 4; ++i) { bf16x4 t = *(const bf16x4*)(p.hb + (size_t)r * D + i * 256 + lane * 4);
#pragma unroll
        for (int j = 0; j < 4; ++j) hv[i * 4 + j] = bf2f((bf16_t)t[j]); }
    __syncthreads();
    const float* U = p.peer_u + (size_t)layer * NEXP * D; const float* V = p.peer_v + (size_t)layer * NEXP * D;
    for (int jj = 0; jj < 32; ++jj) { const int j = w * 32 + jj; const float* ur = U + (size_t)el[j] * D; float s = 0.f;
#pragma unroll
        for (int i = 0; i < 4; ++i) { f32x4 uv = *(const f32x4*)(ur + i * 256 + lane * 4); s += uv[0] * hv[i * 4] + uv[1] * hv[i * 4 + 1] + uv[2] * hv[i * 4 + 2] + uv[3] * hv[i * 4 + 3]; }
        s = wave_sum(s);
        if (lane == 0) wl[j] = p.gate[(size_t)r * 128 + j] * gelu_tanh(s); }
    __syncthreads();
    f32x4 acc = (f32x4){0.f, 0.f, 0.f, 0.f};
    for (int j = 0; j < 128; ++j) { f32x4 vv = *(const f32x4*)(V + (size_t)el[j] * D + tid * 4); acc += vv * wl[j]; }
    const float* g2 = mod_ptr(p, layer, mod_row(p, r), 5) + tid * 4; float* xr = xdst_row(p, r) + tid * 4;
    f32x4 xv = *(f32x4*)xr; xv[0] += g2[0] * acc[0]; xv[1] += g2[1] * acc[1]; xv[2] += g2[2] * acc[2]; xv[3] += g2[3] * acc[3]; *(f32x4*)xr = xv;
}

enum { PH_PROLOGUE = 0, PH_NORM1, PH_GEMM_IN, PH_POST, PH_MIXA, PH_MIXB, PH_MIXC, PH_GLU, PH_GEMM_OUT, PH_NORM2, PH_GEMM_PQ, PH_SCORE, PH_GATHER, PH_COUNT };
__device__ __forceinline__ int rows_out(const Params& p, int layer) { return layer == 0 ? p.NT : p.NTOK; }
__device__ int phase_items(const Params& p, int ph, int layer) {
    const int NCH = p.NT / 128;
    switch (ph) {
        case PH_PROLOGUE: return prologue_items(p);
        case PH_NORM1: return p.NT / 4;
        case PH_GEMM_IN: return (p.NT / 128) * (PROJ / 128);
        case PH_POST: return p.NT / 4;
        case PH_MIXA: return rows_out(p, layer) / 128 * 8 + NCH * 8 + NCH * 4;
        case PH_MIXB: return (p.B * 2 * 16 * 64) / 256 + (p.B * 4 * 2 * 4096) / 256;
        case PH_MIXC: return rows_out(p, layer) / 128 * 4 + rows_out(p, layer) / 128 * 4;
        case PH_GLU: return rows_out(p, layer) / 128 * 2;
        case PH_GEMM_OUT: return rows_out(p, layer) / 128 * (D / 128);
        case PH_NORM2: return rows_out(p, layer) / 4;
        case PH_GEMM_PQ: return rows_out(p, layer) / 128 * (D / 128);
        case PH_SCORE: return rows_out(p, layer) * 2;
        case PH_GATHER: return rows_out(p, layer);
    }
    return 0;
}
template <int ph> __device__ __forceinline__ void phase_body(const Params& p, int layer, int vb, unsigned char* smem) {
    if constexpr (ph == PH_PROLOGUE) phase_prologue(p, vb, smem);
    else if constexpr (ph == PH_NORM1) phase_norm<0>(p, layer, vb, p.NT);
    else if constexpr (ph == PH_GEMM_IN) { EpiStoreF32 e{p.z, PROJ}; gemm_tile(p.hb, D, p.wt_in + (size_t)layer * D * PROJ, D, D, (vb / (PROJ / 128)) * 128, (vb % (PROJ / 128)) * 128, smem, e); }
    else if constexpr (ph == PH_POST) phase_post(p, layer, vb);
    else if constexpr (ph == PH_MIXA) {
        const int na = rows_out(p, layer) / 128 * 8, NCH = p.NT / 128;
        if (vb < na) { const int h = vb & 7, qblk = vb >> 3; const int row0 = qblk * 128;
            if (row0 < p.NTOK) attn_item(p, layer, row0, row0 / p.SEQ, (row0 % p.SEQ) / 128, h, smem);
            else attn_item(p, layer, row0, (row0 - p.NTOK) / p.CTX, -1, h, smem); }
        else if ((vb -= na) < NCH * 8) s5_phaseA(p, layer, vb);
        else ret_phaseA(p, layer, vb - NCH * 8, smem);
    }
    else if constexpr (ph == PH_MIXB) { const int n5 = (p.B * 2 * 16 * 64) / 256; if (vb < n5) s5_phaseB(p, layer, vb); else ret_phaseB(p, layer, vb - n5); }
    else if constexpr (ph == PH_MIXC) { const int n5 = rows_out(p, layer) / 128 * 4; if (vb < n5) s5_phaseC(p, layer, vb, smem); else ret_phaseC(p, layer, vb - n5, smem); }
    else if constexpr (ph == PH_GLU) { EpiGlu e{p.yg, p.mix, p.s5_glu_b + layer * 256}; gemm_tile(p.yg, 256, p.wt_glu + (size_t)layer * 256 * 256, 256, 256, (vb >> 1) * 128, (vb & 1) * 128, smem, e); }
    else if constexpr (ph == PH_GEMM_OUT) { EpiResidual e = make_epi_residual(p, layer); gemm_tile(p.mix, D, p.wt_out + (size_t)layer * D * D, D, D, (vb >> 3) * 128, (vb & 7) * 128, smem, e); }
    else if constexpr (ph == PH_NORM2) phase_norm<1>(p, layer, vb, rows_out(p, layer));
    else if constexpr (ph == PH_GEMM_PQ) { EpiStoreF32 e{p.pq, D}; gemm_tile(p.hb, D, p.wt_pq + (size_t)layer * D * D, D, D, (vb >> 3) * 128, (vb & 7) * 128, smem, e); }
    else if constexpr (ph == PH_SCORE) peer_score(p, layer, vb, smem);
    else if constexpr (ph == PH_GATHER) peer_gather(p, layer, vb, smem);
}

#ifdef CPU_EMU
#define DECL_SMEM unsigned char* smem = EMU_DYN_SMEM()
#else
#define DECL_SMEM extern __shared__ __attribute__((aligned(16))) unsigned char smem[]
#endif

template <int ph> __device__ __forceinline__ void run_phase(const Params& p, int layer, unsigned char* smem) {
    const int n = phase_items(p, ph, layer);
    for (int vb = blockIdx.x; vb < n; vb += gridDim.x) phase_body<ph>(p, layer, vb, smem);
}
template <int ph> __global__ void __launch_bounds__(NTHREADS) k_phase(Params p, int layer) {
    DECL_SMEM;
    run_phase<ph>(p, layer, smem);
}

#ifdef CPU_EMU
extern "C" void emu_check(const char* name, const float* data, long rows, long cols, long ld);
extern "C" void emu_check2(const char* name, const float* data, long rows, long cols, long ld, long rcols, long rcol0);
static void emu_check_bf16(const char* name, const bf16_t* d, long rows, long cols, long ld, long col0, long rcols) {
    float* t = (float*)malloc(rows * cols * 4); for (long r = 0; r < rows; ++r) for (long c = 0; c < cols; ++c) t[r * cols + c] = bf2f(d[r * ld + col0 + c]);
    emu_check2(name, t, rows, cols, cols, rcols, col0); free(t);
}
#endif

static size_t carve(size_t& off, size_t bytes) { size_t o = off; off += (bytes + 255) / 256 * 256; return o; }

extern "C" void kernel_launch(void* const* d_in, const int* in_sizes, int n_in, void* d_out, int out_size, void* d_ws, size_t ws_size, hipStream_t stream) {
    Params p{};
    const float** fp = (const float**)&p.x;
    for (int i = 0; i < 28; ++i) fp[i] = (const float*)d_in[i];
    p.out = (float*)d_out;
    p.B = in_sizes[1] / D; p.SEQ = in_sizes[0] / (p.B * D); p.CTX = in_sizes[2] / (p.B * D);
    p.NTOK = p.B * p.SEQ; p.NCTX = p.B * p.CTX; p.NT = p.NTOK + p.NCTX; p.NLC = p.SEQ / 128; p.NCC = p.CTX / 128;
    char* ws = (char*)d_ws; size_t off = 0; const size_t NT = p.NT, NCH = NT / 128;
    p.mod = (float*)(ws + carve(off, 2 * (p.B + 1) * NMOD * D * 4));
    p.ropeA = (float*)(ws + carve(off, (size_t)p.SEQ * 64 * 4)); p.ropeR = (float*)(ws + carve(off, (size_t)p.SEQ * 64 * 4));
    p.wt_in = (bf16_t*)(ws + carve(off, 2ull * D * PROJ * 2)); p.wt_out = (bf16_t*)(ws + carve(off, 2ull * D * D * 2));
    p.wt_pq = (bf16_t*)(ws + carve(off, 2ull * D * D * 2)); p.wt_glu = (bf16_t*)(ws + carve(off, 2ull * 256 * 256 * 2));
    p.hb = (bf16_t*)(ws + carve(off, NT * D * 2)); p.mix = (bf16_t*)(ws + carve(off, NT * D * 2)); p.yg = (bf16_t*)(ws + carve(off, NT * 256 * 2));
    p.z = (float*)(ws + carve(off, NT * PROJ * 4)); p.pq = p.z;
    p.ctxs = (float*)(ws + carve(off, (size_t)p.NCTX * D * 4));
    p.s5_hend = (float*)(ws + carve(off, NCH * 2 * 16 * 64 * 2 * 4)); p.s5_hin = (float*)(ws + carve(off, NCH * 2 * 16 * 64 * 2 * 4));
    p.ret_kv = (float*)(ws + carve(off, NCH * 4 * 2 * 4096 * 4)); p.ret_sin = (float*)(ws + carve(off, NCH * 4 * 2 * 4096 * 4));
    p.gate = (float*)(ws + carve(off, NT * 128 * 4)); p.eidx = (int*)(ws + carve(off, NT * 128 * 4));
    if (off > ws_size) { fprintf(stderr, "workspace too small: need %zu have %zu\n", off, ws_size); return; }
#ifdef CPU_EMU
    const int grid = 64;
#define RUN(ph, layer) EMU_LAUNCH(k_phase<ph>, grid, NTHREADS, LDS_BYTES, stream, p, layer)
#else
    const int grid = 512;
#define RUN(ph, layer) do { (void)hipFuncSetAttribute((const void*)k_phase<ph>, hipFuncAttributeMaxDynamicSharedMemorySize, LDS_BYTES); hipLaunchKernelGGL(k_phase<ph>, dim3(grid), dim3(NTHREADS), LDS_BYTES, stream, p, layer); } while (0)
#endif
    RUN(PH_PROLOGUE, 0);
#ifdef CPU_EMU
    emu_check("mod0", p.mod, p.B + 1, NMOD * D, NMOD * D);
#define CHK(code) if (layer == 0) { code; }
#else
#define CHK(code)
#endif
    for (int layer = 0; layer < 2; ++layer) {
        RUN(PH_NORM1, layer);
        RUN(PH_GEMM_IN, layer); CHK(emu_check("z0", p.z, NT, PROJ, PROJ))
        RUN(PH_POST, layer);
        RUN(PH_MIXA, layer); CHK(emu_check_bf16("mix0", p.mix, NT, 512, D, 0, D))
        RUN(PH_MIXB, layer);
        RUN(PH_MIXC, layer); CHK(emu_check_bf16("mix0", p.mix, NT, 256, D, 768, D))
        RUN(PH_GLU, layer); CHK(emu_check_bf16("mix0", p.mix, NT, 256, D, 512, D))
        RUN(PH_GEMM_OUT, layer); CHK(emu_check("x1_0", p.out, p.NTOK, D, D))
        RUN(PH_NORM2, layer); CHK(emu_check_bf16("h2_0", p.hb, p.NTOK, D, D, 0, D))
        RUN(PH_GEMM_PQ, layer);
        RUN(PH_SCORE, layer); CHK(float* t = (float*)malloc(NT * 128 * 4); for (size_t i = 0; i < (size_t)p.NTOK * 128; ++i) t[i] = (float)p.eidx[i]; emu_check("eidx0", t, p.NTOK, 128, 128); free(t); emu_check("gate0", p.gate, p.NTOK, 128, 128))
        RUN(PH_GATHER, layer); CHK(emu_check("x2_0", p.out, p.NTOK, D, D); emu_check("ctx2_0", p.ctxs, p.NCTX, D, D))
    }
}
```

```cpp
#ifndef CPU_EMU
#include <hip/hip_runtime.h>
#include <hip/hip_cooperative_groups.h>
#endif
#include <cstdio>
#include <cstdint>
#include <cmath>

#ifndef MEGA
#define MEGA 1
#endif

typedef unsigned short bf16_t;
typedef short bf16x8 __attribute__((ext_vector_type(8)));
typedef short bf16x4 __attribute__((ext_vector_type(4)));
typedef float f32x4 __attribute__((ext_vector_type(4)));
typedef float f32x16 __attribute__((ext_vector_type(16)));
typedef unsigned long long u64;

constexpr int D = 1024, PROJ = 2048, NMOD = 6;
constexpr int NEXP = 16384;
constexpr int NTHREADS = 256;
constexpr int LDS_BYTES = 68608;
constexpr float EPS = 1e-6f;
constexpr int ZQ = 0, ZK = 512, ZV = 640, ZSU = 768, ZRQ = 1024, ZRK = 1280, ZRV = 1536, ZRG = 1792;

#ifdef CPU_EMU
#define GP_AS
#else
#define GP_AS __attribute__((address_space(1)))
#endif
template <class T> struct GP {
    GP_AS T* raw;
    __host__ __device__ __forceinline__ operator T*() const { return (T*)raw; }
    __host__ __device__ __forceinline__ GP& operator=(T* q) { raw = (GP_AS T*)q; return *this; }
};
struct Params {
    GP<const float> x, c, ctx, c_ctx, ada_w, ada_b, norm1_w, norm2_w, w_in, w_out, q_norm_w, k_norm_w, attn_sink,
        s5_a_re, s5_a_im, s5_log_dt, s5_b_re, s5_b_im, s5_c_re, s5_c_im, s5_d, s5_glu_w, s5_glu_b, ret_decay,
        peer_wq, peer_keys, peer_u, peer_v;
    GP<float> out;
    GP<float> mod, ropeA, ropeR, ctxs, s5_hend, s5_hin, ret_kv, ret_sin, gate, ytmp, wbuf;
    GP<bf16_t> wt_in, wt_out, wt_pq, wt_glu, hb, mix, yg, pqb, kb16, zb, akv, po, avt;
    GP<int> eidx; GP<unsigned> bar; GP<unsigned char> ufp8, vfp8; GP<float> uscale, vscale; GP<bf16_t> s5_pt, s5_cm; GP<float> s5_bc, s5_ab;
    int B, SEQ, CTX, NTOK, NCTX, NT, NLC, NCC;
};

#ifdef CPU_EMU
#define GLOBAL_AS
#else
#define GLOBAL_AS __attribute__((address_space(1)))
#endif
#ifdef CPU_EMU
#define WAVE_SYNC() emu::wave_sync()
#else
#define WAVE_SYNC() do { __builtin_amdgcn_fence(__ATOMIC_RELEASE, "wavefront"); __builtin_amdgcn_wave_barrier(); __builtin_amdgcn_fence(__ATOMIC_ACQUIRE, "wavefront"); } while (0)
#endif
#ifdef CPU_EMU
#define OPAQUE_V(x)
#else
#define OPAQUE_V(x) asm volatile("" : "+v"(x))
#endif
#ifdef CPU_EMU
#define UNIFORM(x) (x)
#else
#define UNIFORM(x) __builtin_amdgcn_readfirstlane(x)
#endif
#ifdef CPU_EMU
#define TIDX ((int)threadIdx.x)
#else
__device__ __forceinline__ int tidx_opaque() { int t = threadIdx.x; asm volatile("" : "+v"(t)); return t; }
#define TIDX tidx_opaque()
#endif
__device__ __forceinline__ unsigned f2u(float f) { unsigned u; __builtin_memcpy(&u, &f, 4); return u; }
__device__ __forceinline__ float u2f(unsigned u) { float f; __builtin_memcpy(&f, &u, 4); return f; }
#ifdef CPU_EMU
__device__ __forceinline__ bf16_t f2bf(float f) { unsigned u = f2u(f); u += 0x7fffu + ((u >> 16) & 1u); return (bf16_t)(u >> 16); }
#else
__device__ __forceinline__ bf16_t f2bf(float f) { return __builtin_bit_cast(unsigned short, (__bf16)f); }
#endif
__device__ __forceinline__ float bf2f(bf16_t h) { return u2f(((unsigned)h) << 16); }
__device__ __forceinline__ float gelu_tanh(float x) { const float k = 0.7978845608028654f; float t = k * (x + 0.044715f * x * x * x); return x / (1.f + __expf(-2.f * t)); }
__device__ __forceinline__ float sigmoidf_(float x) { return 1.f / (1.f + __expf(-x)); }
__device__ __forceinline__ float siluf_(float x) { return x / (1.f + __expf(-x)); }
#ifdef CPU_EMU
__device__ __forceinline__ float red16_sum(float v) { v += __shfl_xor(v, 1); v += __shfl_xor(v, 2); v += __shfl_xor(v, 4); v += __shfl_xor(v, 8); return v; }
__device__ __forceinline__ float shx8(float v) { return __shfl_xor(v, 8); }
#else
template <int CTRL> __device__ __forceinline__ float dpp_mov(float v) { return __int_as_float(__builtin_amdgcn_update_dpp(0, __float_as_int(v), CTRL, 0xF, 0xF, false)); }
__device__ __forceinline__ float red16_sum(float v) { v += dpp_mov<0xB1>(v); v += dpp_mov<0x4E>(v); v += dpp_mov<0x141>(v); v += dpp_mov<0x140>(v); return v; }
__device__ __forceinline__ float shx8(float v) { return dpp_mov<0x128>(v); }
#endif
__device__ __forceinline__ float wave_sum(float v) { for (int m = 32; m >= 1; m >>= 1) v += __shfl_xor(v, m); return v; }
__device__ __forceinline__ int mod_row(const Params& p, int r) { return r < p.NTOK ? r / p.SEQ : p.B; }
__device__ __forceinline__ const float* mod_ptr(const Params& p, int layer, int mrow, int which) { return p.mod + ((size_t)(layer * (p.B + 1) + mrow) * NMOD + which) * D; }
__device__ __forceinline__ const float* xsrc_row(const Params& p, int layer, int r) {
    if (layer == 0) return r < p.NTOK ? p.x + (size_t)r * D : p.ctx + (size_t)(r - p.NTOK) * D;
    return r < p.NTOK ? p.out + (size_t)r * D : p.ctxs + (size_t)(r - p.NTOK) * D;
}
__device__ __forceinline__ float* xdst_row(const Params& p, int r) { return r < p.NTOK ? p.out + (size_t)r * D : p.ctxs + (size_t)(r - p.NTOK) * D; }
__device__ __forceinline__ bool chunk_is_ctx(const Params& p, int gc) { return gc >= p.NTOK / 128; }
__device__ __forceinline__ int order_chunk(const Params& p, int b, int dir, int pos) {
    if (pos < p.NCC) { int j = dir ? (p.NCC - 1 - pos) : pos; return p.NTOK / 128 + b * p.NCC + j; }
    int j = pos - p.NCC; if (dir) j = p.NLC - 1 - j; return b * p.NLC + j;
}

__device__ __forceinline__ float* L_hend(const Params& p, int layer) { return p.s5_hend + (size_t)layer * (p.NT / 128) * 4096; }
__device__ __forceinline__ float* L_hin(const Params& p, int layer) { return p.s5_hin + (size_t)layer * (p.NT / 128) * 4096; }
__device__ __forceinline__ float* L_kv(const Params& p, int layer) { return p.ret_kv + (size_t)layer * (p.NT / 128) * 32768; }
__device__ __forceinline__ float* L_sin(const Params& p, int layer) { return p.ret_sin + (size_t)layer * (p.NT / 128) * 32768; }
__device__ __forceinline__ int* L_eidx(const Params& p, int layer) { return p.eidx + (size_t)layer * p.NT * 128; }
__device__ __forceinline__ float* L_wbuf(const Params& p, int layer) { return p.wbuf + (size_t)layer * p.NT * 128; }
__device__ __forceinline__ bf16_t* L_po(const Params& p, int layer) { return p.po + (size_t)layer * p.NT * D; }
__device__ __forceinline__ bf16_t* L_akv(const Params& p, int layer) { return p.akv + (size_t)layer * p.NT * 256; }
__device__ __forceinline__ unsigned f32_to_e4m3(float x) {
    const unsigned u = f2u(x), sign = (u >> 24) & 0x80u; unsigned a = u & 0x7fffffffu;
    if (a >= 0x43E00000u) return sign | 0x7Eu;
    if (a < 0x3C800000u) { const int m = (int)rintf(u2f(a) * 512.f); return sign | (unsigned)m; }
    a += 0x0007FFFFu + ((a >> 20) & 1u);
    return sign | ((((a >> 23) - 120u) << 3) | ((a >> 20) & 7u));
}
__device__ __forceinline__ float e4m3_to_f32_sw(unsigned b) { return u2f(((b & 0x80u) << 24) | ((b & 0x7Fu) << 20)) * 1.329227995784916e36f; }
typedef float f32x2 __attribute__((ext_vector_type(2)));
__device__ __forceinline__ void fp8x4_to_f32(unsigned w, float (&o)[4]) {
#ifdef CPU_EMU
    o[0] = e4m3_to_f32_sw(w & 255u); o[1] = e4m3_to_f32_sw((w >> 8) & 255u); o[2] = e4m3_to_f32_sw((w >> 16) & 255u); o[3] = e4m3_to_f32_sw(w >> 24);
#else
    const f32x2 lo = __builtin_amdgcn_cvt_pk_f32_fp8((int)w, false), hi = __builtin_amdgcn_cvt_pk_f32_fp8((int)w, true);
    o[0] = lo[0]; o[1] = lo[1]; o[2] = hi[0]; o[3] = hi[1];
#endif
}
__device__ __forceinline__ void fp8x4_to_f32x2(unsigned w, f32x2& lo, f32x2& hi) {
#ifdef CPU_EMU
    lo[0] = e4m3_to_f32_sw(w & 255u); lo[1] = e4m3_to_f32_sw((w >> 8) & 255u); hi[0] = e4m3_to_f32_sw((w >> 16) & 255u); hi[1] = e4m3_to_f32_sw(w >> 24);
#else
    lo = __builtin_amdgcn_cvt_pk_f32_fp8((int)w, false); hi = __builtin_amdgcn_cvt_pk_f32_fp8((int)w, true);
#endif
}
constexpr int S5PT_ITEMS = 2 * 2 * 16 * 64 * 128 / 256, S5BC_ITEMS = 2 * 2 * 16 * 64 * 16 / 256 + 2 * 2 * 16 * 16 * 128 / 256;
__device__ __forceinline__ void s5_tables(const Params& p, int vb) {
    const int id = vb * 256 + TIDX;
    if (vb < S5PT_ITEMS) {
        const int tau = id & 127, pp = (id >> 7) & 63, combo = id >> 13, dir = (combo >> 4) & 1, idx = combo * 64 + pp;
        const float are = p.s5_a_re[idx], aim = p.s5_a_im[idx], dt = expf(p.s5_log_dt[idx]), k = (float)(dir ? tau : 127 - tau);
        const float mg = expf(are * dt * k), re = mg * cosf(aim * dt * k), im = mg * sinf(aim * dt * k);
        p.s5_pt[((size_t)combo * 128 + pp) * 128 + tau] = f2bf(re); p.s5_pt[((size_t)combo * 128 + 64 + pp) * 128 + tau] = f2bf(im);
    } else if (vb >= S5PT_ITEMS + 2 * 2 * 16 * 64 * 16 / 256) {
        const int id3 = id - (S5PT_ITEMS + 2 * 2 * 16 * 64 * 16 / 256) * 256, k = id3 & 127, cc = id3 >> 7;
        p.s5_cm[id3] = f2bf(k < 64 ? p.s5_c_re[cc * 64 + k] : -p.s5_c_im[cc * 64 + k - 64]);
    } else {
        const int id2 = id - S5PT_ITEMS * 256, h = id2 & 15, pp = (id2 >> 4) & 63, combo = id2 >> 10, idx = combo * 64 + pp;
        const float are = p.s5_a_re[idx], aim = p.s5_a_im[idx], dt = expf(p.s5_log_dt[idx]);
        const float mg = expf(are * dt), abr = mg * cosf(aim * dt), abi = mg * sinf(aim * dt);
        const float den = 1.f / (are * are + aim * aim), nr = abr - 1.f, ni = abi;
        const float cr = (nr * are + ni * aim) * den, ci = (ni * are - nr * aim) * den;
        const float br = p.s5_b_re[idx * 16 + h], bi = p.s5_b_im[idx * 16 + h];
        p.s5_bc[((size_t)idx * 16 + h) * 2] = cr * br - ci * bi; p.s5_bc[((size_t)idx * 16 + h) * 2 + 1] = cr * bi + ci * br;
        if (h == 0) { const float m128 = expf(are * dt * 128.f);
            p.s5_ab[idx * 4] = abr; p.s5_ab[idx * 4 + 1] = abi; p.s5_ab[idx * 4 + 2] = m128 * cosf(aim * dt * 128.f); p.s5_ab[idx * 4 + 3] = m128 * sinf(aim * dt * 128.f); }
    }
}
__device__ __forceinline__ void transpose_tile(const float* W, bf16_t* Wt, int K, int N, int tile, unsigned char* smem) {
    float* T = (float*)smem;
    const int tn = N / 64, tk0 = (tile / tn) * 64, tn0 = (tile % tn) * 64, tid = TIDX;
    __syncthreads();
    for (int i = 0; i < 16; ++i) { int idx = tid + i * 256, kk = idx >> 6, nn = idx & 63; T[kk * 65 + nn] = W[(size_t)(tk0 + kk) * N + tn0 + nn]; }
    __syncthreads();
    for (int i = 0; i < 16; ++i) { int idx = tid + i * 256, nn = idx >> 6, kk = idx & 63; Wt[(size_t)(tn0 + nn) * K + tk0 + kk] = f2bf(T[kk * 65 + nn]); }
}
constexpr int T_IN = (D / 64) * (PROJ / 64), T_OUT = (D / 64) * (D / 64), T_PQ = T_OUT, T_GLU = 16;
constexpr int T_PER_LAYER = T_IN + T_OUT + T_PQ + T_GLU;
constexpr int MOD_ITEMS = 2 * (NMOD * D / 64);
constexpr int KEY_ITEMS = 2 * 2 * 8 * 128 * 64 / 2048;
constexpr int TAB_ROWS = 2;
constexpr int TAB_ITEMS = 2 * 2 * NEXP / (4 * TAB_ROWS);
__device__ __forceinline__ void phase_prologue(const Params& p, int vb, unsigned char* smem) {
    const int tid = TIDX;
    if (vb < MOD_ITEMS) vb += 2 * T_PER_LAYER; else if (vb < MOD_ITEMS + 2 * T_PER_LAYER) vb -= MOD_ITEMS;
    if (vb < 2 * T_PER_LAYER) {
        int l = vb / T_PER_LAYER, t = vb % T_PER_LAYER;
        if (t < T_IN) transpose_tile(p.w_in + (size_t)l * D * PROJ, p.wt_in + (size_t)l * D * PROJ, D, PROJ, t, smem);
        else if ((t -= T_IN) < T_OUT) transpose_tile(p.w_out + (size_t)l * D * D, p.wt_out + (size_t)l * D * D, D, D, t, smem);
        else if ((t -= T_OUT) < T_PQ) transpose_tile(p.peer_wq + (size_t)l * D * D, p.wt_pq + (size_t)l * D * D, D, D, t, smem);
        else { t -= T_PQ; transpose_tile(p.s5_glu_w + (size_t)l * 256 * 256, p.wt_glu + (size_t)l * 256 * 256, 256, 256, t, smem); }
        return;
    }
    vb -= 2 * T_PER_LAYER;
    if (vb < MOD_ITEMS) {
        const int l = vb / (NMOD * D / 64), col0 = (vb % (NMOD * D / 64)) * 64, nrow = p.B + 1;
        float* sc = (float*)smem;
        float* red = sc + 9 * 1024;
        __syncthreads();
        for (int i = tid; i < nrow * 1024; i += 256) { int r = i >> 10, k = i & 1023; float v = r < p.B ? p.c[r * 1024 + k] : p.c_ctx[k]; sc[i] = siluf_(v); }
        __syncthreads();
        const int cl = tid & 63, ks = tid >> 6;
        float acc[9]; for (int r = 0; r < 9; ++r) acc[r] = 0.f;
        const GLOBAL_AS float* w = (const GLOBAL_AS float*)(p.ada_w + (size_t)l * D * (NMOD * D) + col0 + cl);
#pragma unroll 1
        for (int k0 = ks * 256; k0 < ks * 256 + 256; k0 += 16) { float wv[16];
#pragma unroll
            for (int kk = 0; kk < 16; ++kk) wv[kk] = w[(size_t)(k0 + kk) * (NMOD * D)];
#pragma unroll
            for (int kk = 0; kk < 16; ++kk)
#pragma unroll
                for (int r = 0; r < 9; ++r) acc[r] += sc[r * 1024 + k0 + kk] * wv[kk]; }
#pragma unroll
        for (int r = 0; r < 9; ++r) red[(ks * 9 + r) * 64 + cl] = acc[r];
        __syncthreads();
        for (int i = tid; i < nrow * 64; i += 256) { int r = i >> 6, c2 = i & 63; float s = p.ada_b[l * NMOD * D + col0 + c2];
            for (int q = 0; q < 4; ++q) s += red[(q * 9 + r) * 64 + c2];
            p.mod[(size_t)(l * nrow + r) * NMOD * D + col0 + c2] = s; }
        return;
    }
    vb -= MOD_ITEMS;
    if (vb < KEY_ITEMS) { for (int i = tid; i < 2048; i += 256) p.kb16[(size_t)vb * 2048 + i] = f2bf(p.peer_keys[(size_t)vb * 2048 + i]); return; }
    vb -= KEY_ITEMS;
    if (vb < S5PT_ITEMS + S5BC_ITEMS) { s5_tables(p, vb); return; }
    vb -= S5PT_ITEMS + S5BC_ITEMS;
    if (vb < TAB_ITEMS) {
        const int lane = tid & 63, row0 = (vb * 4 + (tid >> 6)) * TAB_ROWS;
        f32x4 x[TAB_ROWS][4];
#pragma unroll
        for (int q = 0; q < TAB_ROWS; ++q) { const int row = row0 + q, tab = row / (2 * NEXP), rr = row % (2 * NEXP);
            const GLOBAL_AS float* src = (const GLOBAL_AS float*)((tab ? p.peer_v : p.peer_u) + (size_t)rr * D + lane * 16);
#pragma unroll
            for (int i = 0; i < 4; ++i) x[q][i] = *(const GLOBAL_AS f32x4*)(src + i * 4); }
#pragma unroll
        for (int q = 0; q < TAB_ROWS; ++q) { const int row = row0 + q, tab = row / (2 * NEXP), rr = row % (2 * NEXP);
            float amax = 0.f;
#pragma unroll
            for (int i = 0; i < 4; ++i)
#pragma unroll
                for (int j = 0; j < 4; ++j) amax = fmaxf(amax, fabsf(x[q][i][j]));
            for (int m = 32; m >= 1; m >>= 1) amax = fmaxf(amax, __shfl_xor(amax, m));
            const float scale = amax > 0.f ? amax * (1.f / 448.f) : 1.f, inv = 1.f / scale;
            unsigned wq[4];
#pragma unroll
            for (int i = 0; i < 4; ++i) {
#ifdef CPU_EMU
                wq[i] = f32_to_e4m3(x[q][i][0] * inv) | (f32_to_e4m3(x[q][i][1] * inv) << 8) | (f32_to_e4m3(x[q][i][2] * inv) << 16) | (f32_to_e4m3(x[q][i][3] * inv) << 24);
#else
                int pk = __builtin_amdgcn_cvt_pk_fp8_f32(x[q][i][0] * inv, x[q][i][1] * inv, 0, false);
                pk = __builtin_amdgcn_cvt_pk_fp8_f32(x[q][i][2] * inv, x[q][i][3] * inv, pk, true); wq[i] = (unsigned)pk;
#endif
            }
            typedef unsigned u32x4 __attribute__((ext_vector_type(4)));
            unsigned char* dst = tab ? p.vfp8 + ((size_t)((rr / NEXP) * 8 + (lane >> 3)) * NEXP + (rr % NEXP)) * 128 + (lane & 7) * 16
                                     : p.ufp8 + (size_t)rr * D + lane * 16;
            *(u32x4*)dst = (u32x4){wq[0], wq[1], wq[2], wq[3]};
            if (lane == 0) (tab ? p.vscale : p.uscale)[rr] = scale; }
        return;
    }
    vb -= TAB_ITEMS;
    {
        int t = vb * 8 + (tid >> 5), i = tid & 31;
        if (t < p.SEQ) {
            float row = (float)(t / 64), col = (float)(t % 64);
            float inv = powf(10000.0f, -(float)(i & 15) / 16.0f);
            float ang = (i < 16 ? row : col) * inv;
            p.ropeA[(t * 32 + i) * 2] = cosf(ang); p.ropeA[(t * 32 + i) * 2 + 1] = sinf(ang);
            float inv2 = powf(10000.0f, -(float)i / 32.0f); float ang2 = (float)t * inv2;
            p.ropeR[(t * 32 + i) * 2] = cosf(ang2); p.ropeR[(t * 32 + i) * 2 + 1] = sinf(ang2);
        }
    }
}
__device__ __forceinline__ int prologue_items(const Params& p) { return 2 * T_PER_LAYER + MOD_ITEMS + KEY_ITEMS + S5PT_ITEMS + S5BC_ITEMS + TAB_ITEMS + (p.SEQ + 7) / 8; }

template <int WHICH  >
__device__ __forceinline__ void phase_norm(const Params& p, int layer, int vb, int nrows) {
    constexpr int NR = 2;
    const int lane = TIDX & 63, r0 = vb * (4 * NR) + (TIDX >> 6) * NR;
    if (r0 >= nrows) return;
    const float* nw = (WHICH == 0 ? p.norm1_w : p.norm2_w) + layer * D;
    f32x4 v[NR][4]; bf16x4 pv[NR][4]; f32x4 g2[NR][4];
#pragma unroll
    for (int q = 0; q < NR; ++q) { const int r = r0 + q; const float* src = (WHICH == 0) ? xsrc_row(p, layer, r) : xdst_row(p, r); const int mr = mod_row(p, r);
#pragma unroll
        for (int i = 0; i < 4; ++i) { const int c0 = i * 256 + lane * 4; v[q][i] = *(const f32x4*)(src + c0);
            if (WHICH == 0 && layer > 0) { pv[q][i] = *(const bf16x4*)(L_po(p, layer - 1) + (size_t)r * D + c0); g2[q][i] = *(const f32x4*)(mod_ptr(p, layer - 1, mr, 5) + c0); } } }
#pragma unroll
    for (int q = 0; q < NR; ++q) { const int r = r0 + q; const int mr = mod_row(p, r);
        const float* sh = mod_ptr(p, layer, mr, WHICH ? 3 : 0); const float* sc = mod_ptr(p, layer, mr, WHICH ? 4 : 1);
        float ss = 0.f;
#pragma unroll
        for (int i = 0; i < 4; ++i) {
            if (WHICH == 0 && layer > 0) {
                const int c0 = i * 256 + lane * 4;
#pragma unroll
                for (int j = 0; j < 4; ++j) v[q][i][j] += g2[q][i][j] * bf2f((bf16_t)pv[q][i][j]);
                *(f32x4*)(xdst_row(p, r) + c0) = v[q][i]; }
            ss += v[q][i][0] * v[q][i][0] + v[q][i][1] * v[q][i][1] + v[q][i][2] * v[q][i][2] + v[q][i][3] * v[q][i][3]; }
        ss = wave_sum(ss);
        const float rstd = rsqrtf(ss * (1.0f / D) + EPS);
#pragma unroll
        for (int i = 0; i < 4; ++i) { const int c0 = i * 256 + lane * 4; bf16x4 o; const f32x4 nw4 = *(const f32x4*)(nw + c0), sc4 = *(const f32x4*)(sc + c0), sh4 = *(const f32x4*)(sh + c0);
#pragma unroll
            for (int j = 0; j < 4; ++j) { float y = v[q][i][j] * rstd * nw4[j]; y = y * (1.f + sc4[j]) + sh4[j]; o[j] = (short)f2bf(y); }
            *(bf16x4*)(p.hb + (size_t)r * D + c0) = o; } }
}

constexpr int GLD = 72;
template <class Epi>
__device__ __forceinline__ void gemm_tile(const bf16_t* A, int lda, const bf16_t* Bt, int ldb, int K, int m0, int n0, unsigned char* smem, const Epi& epi) {
    bf16_t* As = (bf16_t*)smem; bf16_t* Bs = As + 128 * GLD;
    const int tid = TIDX, lane = tid & 63, wid = tid >> 6, wr = wid >> 1, wc = wid & 1, fr = lane & 15, fq = lane >> 4;
    f32x4 acc[4][4];
#pragma unroll
    for (int i = 0; i < 4; ++i)
#pragma unroll
        for (int j = 0; j < 4; ++j) acc[i][j] = (f32x4){0.f, 0.f, 0.f, 0.f};
    bf16x8 pa[2][4], pb[2][4];
    auto gload = [&](bf16x8 (&qa)[4], bf16x8 (&qb)[4], int k0) {
#pragma unroll
        for (int i = 0; i < 4; ++i) { const int ch = tid + i * 256, row = ch >> 3, cc = ch & 7;
            qa[i] = *(const bf16x8*)(A + (size_t)(m0 + row) * lda + k0 + cc * 8); qb[i] = *(const bf16x8*)(Bt + (size_t)(n0 + row) * ldb + k0 + cc * 8); } };
    auto step = [&](const bf16x8 (&qa)[4], const bf16x8 (&qb)[4]) {
        __syncthreads();
#pragma unroll
        for (int i = 0; i < 4; ++i) { const int ch = tid + i * 256, row = ch >> 3, cc = ch & 7;
            *(bf16x8*)(As + row * GLD + cc * 8) = qa[i]; *(bf16x8*)(Bs + row * GLD + cc * 8) = qb[i]; }
        __syncthreads(); };
    auto mma = [&]() {
#pragma unroll
        for (int kk = 0; kk < 2; ++kk) {
            bf16x8 a[4], b[4];
#pragma unroll
            for (int i = 0; i < 4; ++i) { a[i] = *(const bf16x8*)(As + (wr * 64 + i * 16 + fr) * GLD + kk * 32 + fq * 8); b[i] = *(const bf16x8*)(Bs + (wc * 64 + i * 16 + fr) * GLD + kk * 32 + fq * 8); }
#pragma unroll
            for (int i = 0; i < 4; ++i)
#pragma unroll
                for (int j = 0; j < 4; ++j) acc[i][j] = __builtin_amdgcn_mfma_f32_16x16x32_bf16(a[i], b[j], acc[i][j], 0, 0, 0);
        } };
    gload(pa[0], pb[0], 0); gload(pa[1], pb[1], 64);
    for (int k0 = 0; k0 < K; k0 += 128) {
        step(pa[0], pb[0]); if (k0 + 128 < K) gload(pa[0], pb[0], k0 + 128); mma();
        step(pa[1], pb[1]); if (k0 + 192 < K) gload(pa[1], pb[1], k0 + 192); mma();
    }
    if constexpr (Epi::TILE) { __syncthreads(); epi.tile(acc, m0 + wr * 64, n0 + wc * 64, fr, fq, (bf16_t*)smem + wid * (64 * GLD), lane); }
    else {
#pragma unroll
    for (int i = 0; i < 4; ++i)
#pragma unroll
        for (int j = 0; j < 4; ++j)
#pragma unroll
            for (int r = 0; r < 4; ++r) epi(m0 + wr * 64 + i * 16 + fq * 4 + r, n0 + wc * 64 + j * 16 + fr, acc[i][j][r]);
    }
}
struct EpiStoreF32 { static constexpr bool TILE = false; float* C; int ldc; __device__ __forceinline__ void operator()(int r, int c, float v) const { C[(size_t)r * ldc + c] = v; } };
struct EpiStoreBf16 {
    static constexpr bool TILE = true; bf16_t* C; int ldc;
    __device__ __forceinline__ void tile(const f32x4 (&acc)[4][4], int row0, int c0, int fr, int fq, bf16_t* T, int lane) const {
#pragma unroll
        for (int i = 0; i < 4; ++i)
#pragma unroll
            for (int j = 0; j < 4; ++j)
#pragma unroll
                for (int r = 0; r < 4; ++r) T[(i * 16 + fq * 4 + r) * GLD + j * 16 + fr] = f2bf(acc[i][j][r]);
        WAVE_SYNC();
#pragma unroll
        for (int i = 0; i < 8; ++i) { const int idx = lane + i * 64, rr = idx >> 3, ch = idx & 7;
            *(bf16x8*)(C + (size_t)(row0 + rr) * ldc + c0 + ch * 8) = *(const bf16x8*)(T + rr * GLD + ch * 8); }
        WAVE_SYNC();
    } };
struct EpiResidual {
    static constexpr bool TILE = true;
    const float *src_lat, *src_ctx, *gate; float *dst_lat, *dst_ctx; int NTOK, SEQ, B;
    __device__ __forceinline__ void tile(const f32x4 (&acc)[4][4], int row0, int c0, int fr, int fq, bf16_t* T, int lane) const {
        float* Tf = (float*)T; constexpr int FLD = 68;
#pragma unroll
        for (int half = 0; half < 2; ++half) {
#pragma unroll
            for (int ii = 0; ii < 2; ++ii)
#pragma unroll
                for (int j = 0; j < 4; ++j)
#pragma unroll
                    for (int r = 0; r < 4; ++r) Tf[(ii * 16 + fq * 4 + r) * FLD + j * 16 + fr] = acc[half * 2 + ii][j][r];
            WAVE_SYNC();
#pragma unroll
            for (int k = 0; k < 8; ++k) { const int idx = lane + k * 64, rr = idx >> 4, c4 = idx & 15, row = row0 + half * 32 + rr, col = c0 + c4 * 4;
                const f32x4 v = *(const f32x4*)(Tf + rr * FLD + c4 * 4); const bool lat = row < NTOK;
                const f32x4 g = *(const f32x4*)(gate + (size_t)(lat ? row / SEQ : B) * NMOD * D + col);
                const size_t o = lat ? (size_t)row * D + col : (size_t)(row - NTOK) * D + col;
                const f32x4 x = *(const f32x4*)((lat ? src_lat : src_ctx) + o);
                *(f32x4*)((lat ? dst_lat : dst_ctx) + o) = x + g * v; }
            WAVE_SYNC();
        }
    } };
__device__ __forceinline__ EpiResidual make_epi_residual(const Params& p, int layer) {
    EpiResidual e; e.src_lat = layer == 0 ? p.x : p.out; e.src_ctx = layer == 0 ? p.ctx : p.ctxs; e.dst_lat = p.out; e.dst_ctx = p.ctxs;
    e.gate = p.mod + ((size_t)(layer * (p.B + 1)) * NMOD + 2) * D; e.NTOK = p.NTOK; e.SEQ = p.SEQ; e.B = p.B; return e; }
struct EpiGlu {
    static constexpr bool TILE = true;
    const bf16_t* yg; bf16_t* mix; const float* bias;
    __device__ __forceinline__ void tile(const f32x4 (&acc)[4][4], int row0, int c0, int fr, int fq, bf16_t* T, int lane) const {
        float* Tf = (float*)T; constexpr int FLD = 68;
        float bj[4];
#pragma unroll
        for (int j = 0; j < 4; ++j) bj[j] = bias[c0 + j * 16 + fr];
#pragma unroll
        for (int half = 0; half < 2; ++half) {
#pragma unroll
            for (int ii = 0; ii < 2; ++ii)
#pragma unroll
                for (int j = 0; j < 4; ++j)
#pragma unroll
                    for (int r = 0; r < 4; ++r) Tf[(ii * 16 + fq * 4 + r) * FLD + j * 16 + fr] = sigmoidf_(acc[half * 2 + ii][j][r] + bj[j]);
            WAVE_SYNC();
#pragma unroll
            for (int k = 0; k < 8; ++k) { const int idx = lane + k * 64, rr = idx >> 4, c4 = idx & 15, row = row0 + half * 32 + rr, col = c0 + c4 * 4;
                const f32x4 gt = *(const f32x4*)(Tf + rr * FLD + c4 * 4); const bf16x4 y = *(const bf16x4*)(yg + (size_t)row * 256 + col); bf16x4 o;
#pragma unroll
                for (int e = 0; e < 4; ++e) o[e] = (short)f2bf(bf2f((bf16_t)y[e]) * gt[e]);
                *(bf16x4*)(mix + (size_t)row * D + 512 + col) = o; }
            WAVE_SYNC();
        }
    } };

struct EpiIn {
    static constexpr bool TILE = true;
    const Params* pp; int layer;
    __device__ __forceinline__ void tile(const f32x4 (&acc)[4][4], int row0, int c0, int fr, int fq, bf16_t* T, int lane) const {
        const Params& p = *pp;
        const int unit = c0 >> 6;
        const bool isq = unit < 8, isk = unit >= 8 && unit < 10, isv = unit >= 10 && unit < 12, isrq = unit >= 16 && unit < 20, isrk = unit >= 20 && unit < 24;
        const float* nw = (isq ? p.q_norm_w : p.k_norm_w) + layer * 64;
        bf16_t* akv = L_akv(p, layer);
        if (isv) {
#pragma unroll
            for (int i = 0; i < 4; ++i)
#pragma unroll
                for (int j = 0; j < 4; ++j) { bf16x4 o;
#pragma unroll
                    for (int r = 0; r < 4; ++r) o[r] = (short)f2bf(acc[i][j][r]);
                    *(bf16x4*)(T + (j * 16 + fr) * GLD + i * 16 + fq * 4) = o; }
            WAVE_SYNC();
            bf16_t* dst = p.avt + (size_t)layer * p.NT * 128 + (size_t)(row0 >> 7) * 16384 + (size_t)(c0 - ZV) * 128 + (row0 & 127);
#pragma unroll
            for (int i = 0; i < 8; ++i) { const int idx = lane + i * 64, rr = idx >> 3, ch = idx & 7;
                *(bf16x8*)(dst + rr * 128 + ch * 8) = *(const bf16x8*)(T + rr * GLD + ch * 8); }
            WAVE_SYNC();
            return;
        }
#pragma unroll
        for (int i = 0; i < 4; ++i)
#pragma unroll
            for (int r = 0; r < 4; ++r) {
                const int row = row0 + i * 16 + fq * 4 + r; const bool lat = row < p.NTOK; const int t = lat ? row % p.SEQ : 0;
                float x[4] = {acc[i][0][r], acc[i][1][r], acc[i][2][r], acc[i][3][r]};
                if (isq || isk) {
                    float ss = x[0] * x[0] + x[1] * x[1] + x[2] * x[2] + x[3] * x[3];
                    ss = red16_sum(ss);
                    const float rstd = rsqrtf(ss * (1.f / 64.f) + EPS);
#pragma unroll
                    for (int j = 0; j < 4; ++j) x[j] *= rstd * nw[j * 16 + fr];
                }
                if ((isq || isk || isrq || isrk) && lat) {
                    const float* tab = (isq || isk) ? p.ropeA : p.ropeR;
#pragma unroll
                    for (int j = 0; j < 2; ++j) { const float c = tab[(t * 32 + j * 16 + fr) * 2], sn = tab[(t * 32 + j * 16 + fr) * 2 + 1];
                        const float o1 = x[j] * c - x[j + 2] * sn, o2 = x[j] * sn + x[j + 2] * c; x[j] = o1; x[j + 2] = o2; }
                }
                const float sc = (isq || isrq) ? 0.125f : 1.f;
#pragma unroll
                for (int j = 0; j < 4; ++j) T[(i * 16 + fq * 4 + r) * GLD + j * 16 + fr] = f2bf(x[j] * sc);
            }
        WAVE_SYNC();
        bf16_t* dst; int ld;
        if (isk) { dst = akv + (c0 - ZK); ld = 256; } else { dst = p.zb + c0; ld = PROJ; }
#pragma unroll
        for (int i = 0; i < 8; ++i) { const int idx = lane + i * 64, rr = idx >> 3, ch = idx & 7;
            *(bf16x8*)(dst + (size_t)(row0 + rr) * ld + ch * 8) = *(const bf16x8*)(T + rr * GLD + ch * 8); }
        WAVE_SYNC();
    }
};

constexpr int KLD = 72, VLD = 136;
__device__ __forceinline__ void attn_item(const Params& p, int layer, int qrow0, int b, int qb  , int h, unsigned char* smem) {
    bf16_t* Ks = (bf16_t*)smem; bf16_t* Vt = Ks + 128 * KLD;
    const int tid = TIDX, lane = tid & 63, w = tid >> 6, fr = lane & 15, fq = lane >> 4, hkv = h >> 2;
    bf16x8 qf[2][2];
#pragma unroll
    for (int nt = 0; nt < 2; ++nt)
#pragma unroll
        for (int ks = 0; ks < 2; ++ks) qf[nt][ks] = *(const bf16x8*)(p.zb + (size_t)(qrow0 + w * 32 + nt * 16 + fr) * PROJ + ZQ + h * 64 + ks * 32 + fq * 8);
    const float sink = p.attn_sink[layer * 8 + h];
    float m_[2] = {sink, sink}, l_[2] = {0.f, 0.f};
    f32x4 o[4][2];
#pragma unroll
    for (int i = 0; i < 4; ++i) { o[i][0] = (f32x4){0.f, 0.f, 0.f, 0.f}; o[i][1] = o[i][0]; }
    const int kb0 = qb < 0 ? 0 : (qb > 0 ? qb - 1 : 0), kb1 = qb < 0 ? -1 : (qb + 1 < p.NLC ? qb + 1 : p.NLC - 1);
    const int ntile = p.NCC + (kb1 - kb0 + 1);
    const bf16_t* Kg = L_akv(p, layer) + hkv * 64; const bf16_t* Vg = p.avt + (size_t)layer * p.NT * 128 + hkv * 64 * 128;
    auto tile_row0 = [&](int ti) { return ti < p.NCC ? p.NTOK + b * p.CTX + ti * 128 : b * p.SEQ + (kb0 + (ti - p.NCC)) * 128; };
    bf16x8 kreg[4], vreg[4];
    auto tile_load = [&](int ti) { const int kr = tile_row0(ti);
#pragma unroll
        for (int i = 0; i < 4; ++i) { const int idx = tid + i * 256;
            kreg[i] = *(const bf16x8*)(Kg + (size_t)(kr + (idx >> 3)) * 256 + (idx & 7) * 8);
            vreg[i] = *(const bf16x8*)(Vg + (size_t)(kr >> 7) * 16384 + idx * 8); } };
    tile_load(0);
    for (int ti = 0; ti < ntile; ++ti) {
        int mask = 0;
        if (ti >= p.NCC) { const int kb = kb0 + (ti - p.NCC); mask = (kb < qb) ? 1 : (kb > qb ? 2 : 0); }
        __syncthreads();
#pragma unroll
        for (int i = 0; i < 4; ++i) { const int idx = tid + i * 256;
            *(bf16x8*)(Ks + (idx >> 3) * KLD + (idx & 7) * 8) = kreg[i];
            *(bf16x8*)(Vt + (idx >> 4) * VLD + (idx & 15) * 8) = vreg[i]; }
        __syncthreads();
        if (ti + 1 < ntile) tile_load(ti + 1);
#pragma unroll 1
        for (int kh = 0; kh < 2; ++kh) {
        f32x4 s[4][2];
#pragma unroll
        for (int mt = 0; mt < 4; ++mt) { s[mt][0] = (f32x4){0.f, 0.f, 0.f, 0.f}; s[mt][1] = s[mt][0];
#pragma unroll
            for (int ks = 0; ks < 2; ++ks) { bf16x8 a = *(const bf16x8*)(Ks + (kh * 64 + mt * 16 + fr) * KLD + ks * 32 + fq * 8);
                s[mt][0] = __builtin_amdgcn_mfma_f32_16x16x32_bf16(a, qf[0][ks], s[mt][0], 0, 0, 0);
                s[mt][1] = __builtin_amdgcn_mfma_f32_16x16x32_bf16(a, qf[1][ks], s[mt][1], 0, 0, 0); } }
#pragma unroll
        for (int nt = 0; nt < 2; ++nt) {
            const int qq = w * 32 + nt * 16 + fr; float mx = -3.0e38f;
            const int klo = mask == 1 ? qq : -(1 << 30), khi = mask == 2 ? qq : (1 << 30);
#pragma unroll
            for (int mt = 0; mt < 4; ++mt)
#pragma unroll
                for (int r = 0; r < 4; ++r) { const int kk = kh * 64 + mt * 16 + fq * 4 + r; const float v = (kk >= klo && kk <= khi) ? s[mt][nt][r] : -3.0e38f; s[mt][nt][r] = v; mx = fmaxf(mx, v); }
            mx = fmaxf(mx, __shfl_xor(mx, 16)); mx = fmaxf(mx, __shfl_xor(mx, 32));
            const float mn = fmaxf(m_[nt], mx), alpha = __expf(m_[nt] - mn); m_[nt] = mn; float ls = 0.f;
#pragma unroll
            for (int mt = 0; mt < 4; ++mt)
#pragma unroll
                for (int r = 0; r < 4; ++r) { float e = __expf(s[mt][nt][r] - mn); s[mt][nt][r] = e; ls += e; }
            l_[nt] = l_[nt] * alpha + ls;
#pragma unroll
            for (int dt = 0; dt < 4; ++dt) o[dt][nt] *= alpha;
        }
#pragma unroll
        for (int ks2 = 0; ks2 < 2; ++ks2) {
            bf16x8 pb[2];
#pragma unroll
            for (int nt = 0; nt < 2; ++nt)
#pragma unroll
                for (int j = 0; j < 8; ++j) pb[nt][j] = (short)f2bf(s[2 * ks2 + (j >> 2)][nt][j & 3]);
#pragma unroll
            for (int dt = 0; dt < 4; ++dt) { const bf16_t* vp = Vt + (dt * 16 + fr) * VLD + kh * 64 + fq * 4;
                bf16x4 v0 = *(const bf16x4*)(vp + (2 * ks2) * 16), v1 = *(const bf16x4*)(vp + (2 * ks2 + 1) * 16);
                bf16x8 a = (bf16x8){v0[0], v0[1], v0[2], v0[3], v1[0], v1[1], v1[2], v1[3]};
                o[dt][0] = __builtin_amdgcn_mfma_f32_16x16x32_bf16(a, pb[0], o[dt][0], 0, 0, 0);
                o[dt][1] = __builtin_amdgcn_mfma_f32_16x16x32_bf16(a, pb[1], o[dt][1], 0, 0, 0); }
        }
        }
    }
#pragma unroll
    for (int nt = 0; nt < 2; ++nt) {
        float l = l_[nt]; l += __shfl_xor(l, 16); l += __shfl_xor(l, 32); l += __expf(sink - m_[nt]);
        const float inv = 1.f / l; const int row = qrow0 + w * 32 + nt * 16 + fr;
#pragma unroll
        for (int dt = 0; dt < 4; ++dt) { bf16x4 ov;
#pragma unroll
            for (int r = 0; r < 4; ++r) ov[r] = (short)f2bf(o[dt][nt][r] * inv);
            *(bf16x4*)(p.mix + (size_t)row * D + h * 64 + dt * 16 + fq * 4) = ov; }
    }
}

struct cplx { float re, im; };
__device__ __forceinline__ cplx cmul(cplx a, cplx b) { return {a.re * b.re - a.im * b.im, a.re * b.im + a.im * b.re}; }
__device__ __forceinline__ void s5_disc(const Params& p, int layer, int dir, int g, int pp, float pw, cplx& abar, cplx& coef) {
    const int idx = ((layer * 2 + dir) * 16 + g) * 64 + pp;
    const float are = p.s5_a_re[idx], aim = p.s5_a_im[idx], dt = expf(p.s5_log_dt[idx]);
    const float mg = expf(are * dt); abar = {mg * cosf(aim * dt), mg * sinf(aim * dt)};
    const float den = 1.f / (are * are + aim * aim); const float nr = abar.re - 1.f, ni = abar.im;
    coef = {(nr * are + ni * aim) * den, (ni * are - nr * aim) * den};
    if (pw != 1.f) { const float mgp = expf(are * dt * pw); abar = {mgp * cosf(aim * dt * pw), mgp * sinf(aim * dt * pw)}; }
}
__device__ __forceinline__ void s5_stage_u(const Params& p, int gc, int g, int lane, float* U) {
#pragma unroll
    for (int i = 0; i < 4; ++i) { const int row = i * 32 + (lane >> 1), q = lane & 1;
        const bf16x8 u8 = *(const bf16x8*)(p.zb + (size_t)(gc * 128 + row) * PROJ + ZSU + g * 16 + q * 8);
#pragma unroll
        for (int e = 0; e < 8; ++e) U[row * 16 + q * 8 + e] = bf2f((bf16_t)u8[e]); }
    WAVE_SYNC();
}
__device__ __forceinline__ void s5_phaseA(const Params& p, int layer, int vb, unsigned char* smem) {
    constexpr int ULD = 136;
    const int lane = TIDX & 63, w = TIDX >> 6, fr = lane & 15, fq = lane >> 4;
    const int dir = vb & 1, gq = (vb >> 1) & 3, gc = vb >> 3, g = gq * 4 + w, combo = (layer * 2 + dir) * 16 + g;
    bf16_t* UT = (bf16_t*)smem + w * (16 * ULD);
    const bf16_t* PT = p.s5_pt + (size_t)combo * 128 * 128;
    const float* BC = p.s5_bc + (size_t)combo * 64 * 16 * 2;
    bf16x8 u8[4], pt[2][8]; f32x2 bc[16];
#pragma unroll
    for (int i = 0; i < 4; ++i) u8[i] = *(const bf16x8*)(p.zb + (size_t)(gc * 128 + i * 32 + (lane >> 1)) * PROJ + ZSU + g * 16 + (lane & 1) * 8);
#pragma unroll
    for (int ks = 0; ks < 2; ++ks)
#pragma unroll
        for (int mt = 0; mt < 8; ++mt) pt[ks][mt] = *(const bf16x8*)(PT + (size_t)(mt * 16 + fr) * 128 + ks * 32 + fq * 8);
#pragma unroll
    for (int q = 0; q < 16; ++q) bc[q] = *(const f32x2*)(BC + ((size_t)((q >> 2) * 16 + fq * 4 + (q & 3)) * 16 + fr) * 2);
    __syncthreads();
#pragma unroll
    for (int i = 0; i < 4; ++i) { const int row = i * 32 + (lane >> 1), q = lane & 1;
#pragma unroll
        for (int e = 0; e < 8; ++e) UT[(q * 8 + e) * ULD + row] = (bf16_t)u8[i][e]; }
    WAVE_SYNC();
    f32x4 acc[8];
#pragma unroll
    for (int mt = 0; mt < 8; ++mt) acc[mt] = (f32x4){0.f, 0.f, 0.f, 0.f};
#pragma unroll
    for (int ks = 0; ks < 4; ++ks) { const bf16x8 b = *(const bf16x8*)(UT + fr * ULD + ks * 32 + fq * 8);
#pragma unroll
        for (int mt = 0; mt < 8; ++mt) { const bf16x8 a = ks < 2 ? pt[ks & 1][mt] : *(const bf16x8*)(PT + (size_t)(mt * 16 + fr) * 128 + ks * 32 + fq * 8); acc[mt] = __builtin_amdgcn_mfma_f32_16x16x32_bf16(a, b, acc[mt], 0, 0, 0); } }
    float* dst = L_hend(p, layer) + ((((size_t)gc * 2 + dir) * 16 + g) * 64) * 2;
#pragma unroll
    for (int mt = 0; mt < 4; ++mt)
#pragma unroll
        for (int r = 0; r < 4; ++r) { const int pp = mt * 16 + fq * 4 + r; const f32x2 bq = bc[mt * 4 + r];
            const float wre = acc[mt][r], wim = acc[mt + 4][r];
            float hr = bq[0] * wre - bq[1] * wim, hi = bq[0] * wim + bq[1] * wre;
            hr = red16_sum(hr); hi = red16_sum(hi);
            if (fr == 0) { dst[pp * 2] = hr; dst[pp * 2 + 1] = hi; } }
}
__device__ __forceinline__ void s5_phaseB(const Params& p, int layer, int vb) {
    const int idx = vb * 256 + TIDX; if (idx >= p.B * 2 * 16 * 64) return;
    const int pp = idx & 63, g = (idx >> 6) & 15, dir = (idx >> 10) & 1, b = idx >> 11;
    const float* abp = p.s5_ab + ((size_t)((layer * 2 + dir) * 16 + g) * 64 + pp) * 4; const cplx a128 = {abp[2], abp[3]};
    float zero = 0.f; OPAQUE_V(zero);
    cplx H = {zero, zero};
    const int npos = p.NCC + p.NLC; constexpr int MAXPOS = 18;
    if (npos <= MAXPOS) {
        f32x2 he[MAXPOS];
#pragma unroll
        for (int pos = 0; pos < MAXPOS; ++pos) if (pos < npos) { const int gc = order_chunk(p, b, dir, pos); he[pos] = *(const f32x2*)(L_hend(p, layer) + ((((size_t)gc * 2 + dir) * 16 + g) * 64 + pp) * 2); }
#pragma unroll
        for (int pos = 0; pos < MAXPOS; ++pos) if (pos < npos) { const int gc = order_chunk(p, b, dir, pos); const size_t o = ((((size_t)gc * 2 + dir) * 16 + g) * 64 + pp) * 2;
            *(f32x2*)(L_hin(p, layer) + o) = (f32x2){H.re, H.im};
            cplx nh = cmul(a128, H); H = {nh.re + he[pos][0], nh.im + he[pos][1]}; }
    } else
    for (int pos = 0; pos < npos; ++pos) {
        const int gc = order_chunk(p, b, dir, pos); const size_t o = ((((size_t)gc * 2 + dir) * 16 + g) * 64 + pp) * 2;
        L_hin(p, layer)[o] = H.re; L_hin(p, layer)[o + 1] = H.im;
        cplx nh = cmul(a128, H); H = {nh.re + L_hend(p, layer)[o], nh.im + L_hend(p, layer)[o + 1]};
    }
}
constexpr int S5_WAVE_LDS = 8192 + 4352, S5_HLD = 136;
__device__ __forceinline__ void s5_phaseC(const Params& p, int layer, int vb, unsigned char* smem) {
    const int lane = TIDX & 63, w = TIDX >> 6, gq = vb & 3, gc = vb >> 2, g = gq * 4 + w, fr = lane & 15, fq = lane >> 4;
    float* U = (float*)(smem + w * S5_WAVE_LDS); bf16_t* H = (bf16_t*)(U + 2048);
    __syncthreads();
    s5_stage_u(p, gc, g, lane, U);
#pragma unroll 1
    for (int dir = 0; dir < 2; ++dir) {
        const int combo = (layer * 2 + dir) * 16 + g;
        const f32x2 abv = *(const f32x2*)(p.s5_ab + ((size_t)combo * 64 + lane) * 4);
        const size_t ho = ((((size_t)gc * 2 + dir) * 16 + g) * 64 + lane) * 2;
        const f32x2 hv = *(const f32x2*)(L_hin(p, layer) + ho);
        float bre[16], bim[16];
#pragma unroll
        for (int q = 0; q < 8; ++q) { const f32x4 bq = *(const f32x4*)(p.s5_bc + ((size_t)combo * 64 + lane) * 32 + q * 4); bre[2 * q] = bq[0]; bim[2 * q] = bq[1]; bre[2 * q + 1] = bq[2]; bim[2 * q + 1] = bq[3]; }
        bf16x8 cmf[4];
#pragma unroll
        for (int ks = 0; ks < 4; ++ks) cmf[ks] = *(const bf16x8*)(p.s5_cm + ((size_t)combo * 16 + fr) * 128 + ks * 32 + fq * 8);
        const cplx ab = {abv[0], abv[1]}; cplx hs = {hv[0], hv[1]};
#pragma unroll 1
        for (int s = 0; s < 8; ++s) {
            const int sub = dir ? 7 - s : s;
#pragma unroll 4
            for (int t = 0; t < 16; ++t) {
                const int tl = dir ? 15 - t : t; const float* u = U + (sub * 16 + tl) * 16;
                float br = 0.f, bi2 = 0.f;
#pragma unroll
                for (int h = 0; h < 16; ++h) { const float uv = u[h]; br += bre[h] * uv; bi2 += bim[h] * uv; }
                cplx nh = cmul(ab, hs); hs = {nh.re + br, nh.im + bi2};
                H[tl * S5_HLD + lane] = f2bf(hs.re); H[tl * S5_HLD + 64 + lane] = f2bf(hs.im);
            }
            WAVE_SYNC();
            f32x4 acc = (f32x4){0.f, 0.f, 0.f, 0.f};
#pragma unroll
            for (int ks = 0; ks < 4; ++ks) { const bf16x8 af = *(const bf16x8*)(H + fr * S5_HLD + ks * 32 + fq * 8); acc = __builtin_amdgcn_mfma_f32_16x16x32_bf16(af, cmf[ks], acc, 0, 0, 0); }
#pragma unroll
            for (int r = 0; r < 4; ++r) { const int tk = sub * 16 + fq * 4 + r, row = gc * 128 + tk;
                float* yt = p.ytmp + (size_t)gc * 65536 + ((size_t)g * 128 + tk) * 16 + fr;
                if (dir == 0) *yt = acc[r];
                else p.yg[(size_t)row * 256 + g * 16 + fr] = f2bf(gelu_tanh(*yt + acc[r] + p.s5_d[layer * 256 + g * 16 + fr] * U[tk * 16 + fr])); }
            WAVE_SYNC();
        }
    }
}

__device__ __forceinline__ float ret_loggamma(const Params& p, int layer, int dir, int h) { const float x = p.ret_decay[(layer * 2 + dir) * 4 + h]; return -log1pf(expf(-x)); }
__device__ __forceinline__ void ret_phaseA(const Params& p, int layer, int vb, unsigned char* smem) {
    constexpr int RLD = 136;
    const int tid = TIDX, lane = tid & 63, w = tid >> 6, fr = lane & 15, fq = lane >> 4, h = vb & 3, gc = vb >> 2;
    bf16_t* Kt = (bf16_t*)smem; bf16_t* Vt = Kt + 64 * RLD;
    __syncthreads();
#pragma unroll
    for (int i = 0; i < 4; ++i) { const int idx = tid + i * 256, m = idx >> 3, d8 = idx & 7; const bf16_t* src = p.zb + (size_t)(gc * 128 + m) * PROJ + h * 64 + d8 * 8;
        const bf16x8 k8 = *(const bf16x8*)(src + ZRK), v8 = *(const bf16x8*)(src + ZRV);
#pragma unroll
        for (int c = 0; c < 8; ++c) { Kt[(d8 * 8 + c) * RLD + m] = (bf16_t)k8[c]; Vt[(d8 * 8 + c) * RLD + m] = (bf16_t)v8[c]; } }
    __syncthreads();
    const float lgf = ret_loggamma(p, layer, 0, h), lgb = ret_loggamma(p, layer, 1, h);
    f32x4 acc[2][4];
#pragma unroll
    for (int dir = 0; dir < 2; ++dir)
#pragma unroll
        for (int dt = 0; dt < 4; ++dt) acc[dir][dt] = (f32x4){0.f, 0.f, 0.f, 0.f};
#pragma unroll
    for (int ks = 0; ks < 4; ++ks) {
        const int m0 = ks * 32 + fq * 8;
        const bf16x8 v8 = *(const bf16x8*)(Vt + (w * 16 + fr) * RLD + m0);
        bf16x8 af, ab;
#pragma unroll
        for (int j = 0; j < 8; ++j) { const float v = bf2f((bf16_t)v8[j]); af[j] = (short)f2bf(v * __expf(lgf * (float)(127 - (m0 + j)))); ab[j] = (short)f2bf(v * __expf(lgb * (float)(m0 + j))); }
#pragma unroll
        for (int dt = 0; dt < 4; ++dt) { const bf16x8 b = *(const bf16x8*)(Kt + (dt * 16 + fr) * RLD + m0);
            acc[0][dt] = __builtin_amdgcn_mfma_f32_16x16x32_bf16(af, b, acc[0][dt], 0, 0, 0);
            acc[1][dt] = __builtin_amdgcn_mfma_f32_16x16x32_bf16(ab, b, acc[1][dt], 0, 0, 0); }
    }
#pragma unroll
    for (int dir = 0; dir < 2; ++dir) { float* o = L_kv(p, layer) + (((size_t)gc * 4 + h) * 2 + dir) * 4096;
#pragma unroll
        for (int dt = 0; dt < 4; ++dt)
#pragma unroll
            for (int r = 0; r < 4; ++r) o[(w * 16 + fq * 4 + r) * 64 + dt * 16 + fr] = acc[dir][dt][r]; }
}
__device__ __forceinline__ void ret_phaseB(const Params& p, int layer, int vb) {
    const int id = vb * 256 + TIDX; if (id >= p.B * 4 * 2 * 4096) return;
    const int i = id & 4095, dir = (id >> 12) & 1, h = (id >> 13) & 3, b = id >> 15;
    const float g128 = expf(128.f * ret_loggamma(p, layer, dir, h)); float S = 0.f;
    const int npos = p.NCC + p.NLC; constexpr int MAXPOS = 18;
    if (npos <= MAXPOS) {
        float kvv[MAXPOS];
#pragma unroll
        for (int pos = 0; pos < MAXPOS; ++pos) if (pos < npos) { const int gc = order_chunk(p, b, dir, pos); kvv[pos] = L_kv(p, layer)[(((size_t)gc * 4 + h) * 2 + dir) * 4096 + i]; }
#pragma unroll
        for (int pos = 0; pos < MAXPOS; ++pos) if (pos < npos) { const int gc = order_chunk(p, b, dir, pos); L_sin(p, layer)[(((size_t)gc * 4 + h) * 2 + dir) * 4096 + i] = S; S = g128 * S + kvv[pos]; }
    } else
    for (int pos = 0; pos < npos; ++pos) { const int gc = order_chunk(p, b, dir, pos); const size_t o = (((size_t)gc * 4 + h) * 2 + dir) * 4096 + i;
        L_sin(p, layer)[o] = S; S = g128 * S + L_kv(p, layer)[o]; }
}
__device__ __forceinline__ void ret_phaseC(const Params& p, int layer, int vb, unsigned char* smem) {
    const int tid = TIDX, lane = tid & 63, w = tid >> 6, fr = lane & 15, fq = lane >> 4, h = vb & 3, gc = vb >> 2;
    bf16_t* Ks = (bf16_t*)smem; bf16_t* Vt = Ks + 128 * KLD; bf16_t* Sf = Vt + 64 * VLD; bf16_t* Sb = Sf + 64 * KLD;
    const float lgf = ret_loggamma(p, layer, 0, h), lgb = ret_loggamma(p, layer, 1, h);
    const int row0 = gc * 128;
    __syncthreads();
#pragma unroll
    for (int i = 0; i < 4; ++i) { const int idx = tid + i * 256, key = idx >> 3, d8 = idx & 7; const bf16_t* src = p.zb + (size_t)(row0 + key) * PROJ + h * 64 + d8 * 8;
        const bf16x8 kv = *(const bf16x8*)(src + ZRK), vv = *(const bf16x8*)(src + ZRV);
        *(bf16x8*)(Ks + key * KLD + d8 * 8) = kv;
#pragma unroll
        for (int c = 0; c < 8; ++c) Vt[(d8 * 8 + c) * VLD + key] = (bf16_t)vv[c]; }
    { const float* sf = L_sin(p, layer) + (((size_t)gc * 4 + h) * 2) * 4096;
#pragma unroll
      for (int i = 0; i < 8; ++i) { const int idx = tid + i * 256, which = idx >> 10, e = (idx >> 4) & 63, d4 = idx & 15; f32x4 v = *(const f32x4*)(sf + which * 4096 + e * 64 + d4 * 4);
          *(bf16x4*)((which ? Sb : Sf) + e * KLD + d4 * 4) = (bf16x4){(short)f2bf(v[0]), (short)f2bf(v[1]), (short)f2bf(v[2]), (short)f2bf(v[3])}; } }
    __syncthreads();
    bf16x8 qf[2][2]; float wf[2], wb[2];
#pragma unroll
    for (int nt = 0; nt < 2; ++nt) { const int c = w * 32 + nt * 16 + fr; wf[nt] = __expf(lgf * (c + 1)); wb[nt] = __expf(lgb * (128 - c));
#pragma unroll
        for (int ks = 0; ks < 2; ++ks) qf[nt][ks] = *(const bf16x8*)(p.zb + (size_t)(row0 + c) * PROJ + ZRQ + h * 64 + ks * 32 + fq * 8); }
    f32x4 o[4][2];
#pragma unroll
    for (int dt = 0; dt < 4; ++dt) {
        f32x4 xf[2], xb[2]; xf[0] = xf[1] = xb[0] = xb[1] = (f32x4){0.f, 0.f, 0.f, 0.f};
#pragma unroll
        for (int ks = 0; ks < 2; ++ks) { bf16x8 af = *(const bf16x8*)(Sf + (dt * 16 + fr) * KLD + ks * 32 + fq * 8), ab = *(const bf16x8*)(Sb + (dt * 16 + fr) * KLD + ks * 32 + fq * 8);
#pragma unroll
            for (int nt = 0; nt < 2; ++nt) { xf[nt] = __builtin_amdgcn_mfma_f32_16x16x32_bf16(af, qf[nt][ks], xf[nt], 0, 0, 0); xb[nt] = __builtin_amdgcn_mfma_f32_16x16x32_bf16(ab, qf[nt][ks], xb[nt], 0, 0, 0); } }
#pragma unroll
        for (int nt = 0; nt < 2; ++nt) o[dt][nt] = xf[nt] * wf[nt] + xb[nt] * wb[nt];
    }
#pragma unroll 1
    for (int kh = 0; kh < 2; ++kh) {
        f32x4 s[4][2];
#pragma unroll
        for (int mt = 0; mt < 4; ++mt) { s[mt][0] = (f32x4){0.f, 0.f, 0.f, 0.f}; s[mt][1] = s[mt][0];
#pragma unroll
            for (int ks = 0; ks < 2; ++ks) { bf16x8 a = *(const bf16x8*)(Ks + (kh * 64 + mt * 16 + fr) * KLD + ks * 32 + fq * 8);
                s[mt][0] = __builtin_amdgcn_mfma_f32_16x16x32_bf16(a, qf[0][ks], s[mt][0], 0, 0, 0);
                s[mt][1] = __builtin_amdgcn_mfma_f32_16x16x32_bf16(a, qf[1][ks], s[mt][1], 0, 0, 0); } }
#pragma unroll
        for (int nt = 0; nt < 2; ++nt) { const int c = w * 32 + nt * 16 + fr;
#pragma unroll
            for (int mt = 0; mt < 4; ++mt)
#pragma unroll
                for (int r = 0; r < 4; ++r) { const int dlt = c - (kh * 64 + mt * 16 + fq * 4 + r);
                    const float ex = __expf((dlt > 0 ? lgf : lgb) * (float)(dlt > 0 ? dlt : -dlt)); s[mt][nt][r] *= (dlt == 0 ? 2.f : ex); } }
#pragma unroll
        for (int ks2 = 0; ks2 < 2; ++ks2) {
            bf16x8 pb[2];
#pragma unroll
            for (int nt = 0; nt < 2; ++nt)
#pragma unroll
                for (int j = 0; j < 8; ++j) pb[nt][j] = (short)f2bf(s[2 * ks2 + (j >> 2)][nt][j & 3]);
#pragma unroll
            for (int dt = 0; dt < 4; ++dt) { const bf16_t* vp = Vt + (dt * 16 + fr) * VLD + kh * 64 + fq * 4;
                bf16x4 v0 = *(const bf16x4*)(vp + (2 * ks2) * 16), v1 = *(const bf16x4*)(vp + (2 * ks2 + 1) * 16);
                bf16x8 a = (bf16x8){v0[0], v0[1], v0[2], v0[3], v1[0], v1[1], v1[2], v1[3]};
                o[dt][0] = __builtin_amdgcn_mfma_f32_16x16x32_bf16(a, pb[0], o[dt][0], 0, 0, 0);
                o[dt][1] = __builtin_amdgcn_mfma_f32_16x16x32_bf16(a, pb[1], o[dt][1], 0, 0, 0); }
        }
    }
#pragma unroll
    for (int nt = 0; nt < 2; ++nt) { float ss = 0.f;
#pragma unroll
        for (int dt = 0; dt < 4; ++dt)
#pragma unroll
            for (int r = 0; r < 4; ++r) ss += o[dt][nt][r] * o[dt][nt][r];
        ss += __shfl_xor(ss, 16); ss += __shfl_xor(ss, 32);
        const float rstd = rsqrtf(ss * (1.f / 64.f) + EPS); const int row = row0 + w * 32 + nt * 16 + fr;
#pragma unroll
        for (int dt = 0; dt < 4; ++dt) { const int e0 = dt * 16 + fq * 4; const bf16x4 gv = *(const bf16x4*)(p.zb + (size_t)row * PROJ + ZRG + h * 64 + e0); bf16x4 ov;
#pragma unroll
            for (int r = 0; r < 4; ++r) ov[r] = (short)f2bf(o[dt][nt][r] * rstd * siluf_(bf2f((bf16_t)gv[r])));
            *(bf16x4*)(p.mix + (size_t)row * D + 768 + h * 64 + e0) = ov; }
    }
}

__device__ __forceinline__ float emb(float v, unsigned idx, unsigned mask) { return u2f((f2u(v) & ~mask) | idx); }
__device__ __forceinline__ void cex_desc(float& a, float& b) { const float hi = fmaxf(a, b), lo = fminf(a, b); a = hi; b = lo; }
__device__ __forceinline__ void sort16_desc(float* v) {
#pragma unroll
    for (int k = 2; k <= 16; k <<= 1)
#pragma unroll
        for (int j = k >> 1; j > 0; j >>= 1)
#pragma unroll
            for (int i = 0; i < 16; ++i) { const int l = i ^ j; if (l > i) { if ((i & k) == 0) cex_desc(v[i], v[l]); else cex_desc(v[l], v[i]); } }
}
__device__ __forceinline__ void merge_top16(float* a, const float* b) {
#pragma unroll
    for (int i = 0; i < 16; ++i) a[i] = fmaxf(a[i], b[15 - i]);
#pragma unroll
    for (int j = 8; j > 0; j >>= 1)
#pragma unroll
        for (int i = 0; i < 16; ++i) { const int l = i ^ j; if (l > i) cex_desc(a[i], a[l]); }
}
__device__ __forceinline__ void top16_of_64(float* v) {
    sort16_desc(v); sort16_desc(v + 16); sort16_desc(v + 32); sort16_desc(v + 48);
    merge_top16(v, v + 16); merge_top16(v + 32, v + 48); merge_top16(v, v + 32);
}
__device__ __forceinline__ void peer_score(const Params& p, int layer, int vb, unsigned char* smem) {
    const int lane = TIDX & 63, w = TIDX >> 6, hq = vb & 1, tg = (vb >> 1) & 3, rb = vb >> 3, h = hq * 4 + w;
    const int tok = rb * 128 + tg * 32 + (lane & 31), l5 = lane >> 5;
    float* L = (float*)smem + w * (3 * 16 * 64);
    float* Ls = L; float* Lt1 = L + 1024; float* Lt2 = L + 2048;
    __syncthreads();
#pragma unroll 1
    for (int half = 0; half < 2; ++half) {
        f32x16 acc[4];
#pragma unroll
        for (int mt = 0; mt < 4; ++mt)
#pragma unroll
            for (int r = 0; r < 16; ++r) acc[mt][r] = 0.f;
        const bf16_t* qp = p.pqb + (size_t)tok * D + h * 128 + half * 64 + 8 * l5;
        const bf16_t* kp = p.kb16 + ((((size_t)layer * 2 + half) * 8 + h) * 128 + (lane & 31)) * 64 + 8 * l5;
#pragma unroll
        for (int ks = 0; ks < 4; ++ks) { const bf16x8 b = *(const bf16x8*)(qp + ks * 16);
#pragma unroll
            for (int mt = 0; mt < 4; ++mt) { const bf16x8 a = *(const bf16x8*)(kp + (size_t)mt * 32 * 64 + ks * 16); acc[mt] = __builtin_amdgcn_mfma_f32_32x32x16_bf16(a, b, acc[mt], 0, 0, 0); } }
        float v[64];
#pragma unroll
        for (int mt = 0; mt < 4; ++mt)
#pragma unroll
            for (int r = 0; r < 16; ++r) v[mt * 16 + r] = emb(acc[mt][r], (unsigned)(mt * 32 + (r & 3) + 8 * (r >> 2) + 4 * l5), 127u);
        top16_of_64(v);
#pragma unroll
        for (int i = 0; i < 16; ++i) Ls[i * 64 + lane] = v[i];
        WAVE_SYNC();
        float u[16];
#pragma unroll
        for (int i = 0; i < 16; ++i) u[i] = Ls[i * 64 + (lane ^ 32)];
        WAVE_SYNC();
        merge_top16(v, u);
        float* Lt = half ? Lt2 : Lt1;
#pragma unroll
        for (int i = 0; i < 16; ++i) Lt[i * 64 + lane] = v[i];
    }
    float t1[16], t2[16];
#pragma unroll
    for (int i = 0; i < 16; ++i) { t1[i] = u2f(f2u(Lt1[i * 64 + lane]) & ~127u); t2[i] = u2f(f2u(Lt2[i * 64 + lane]) & ~127u); }
    float c[64];
    {
        int pidx = 0;
#pragma unroll
        for (int i = 0; i < 16; ++i)
#pragma unroll
            for (int j = 0; j < 16; ++j) if ((i + 1) * (j + 1) <= 16) { c[pidx] = emb(t1[i] + t2[j], (unsigned)pidx, 63u); ++pidx; }
#pragma unroll
        for (int q = 50; q < 64; ++q) c[q] = -3.0e38f;
    }
    top16_of_64(c);
    float best[16];
#pragma unroll
    for (int it = 0; it < 16; ++it) best[it] = c[it];
    const float mx = u2f(f2u(best[0]) & ~63u); float e[16], ssum = 0.f;
#pragma unroll
    for (int it = 0; it < 16; ++it) { e[it] = __expf(u2f(f2u(best[it]) & ~63u) - mx); ssum += e[it]; }
    const float inv = 1.f / ssum;
#pragma unroll
    for (int it = 0; it < 16; ++it) {
        if ((it >> 3) == l5) {
            const int pidx = (int)(f2u(best[it]) & 63u); int ii = 0, st = 0;
            { int q = 0;
#pragma unroll
              for (int i = 0; i < 16; ++i) { if (pidx >= q) { ii = i; st = q; } q += 16 / (i + 1); } }
            const int jj = pidx - st;
            const unsigned k1 = f2u(Lt1[ii * 64 + lane]) & 127u, k2 = f2u(Lt2[jj * 64 + lane]) & 127u;
            p.gate[(size_t)tok * 128 + h * 16 + it] = e[it] * inv; L_eidx(p, layer)[(size_t)tok * 128 + h * 16 + it] = (int)(k1 * 128u + k2);
        }
    }
}
__device__ __forceinline__ void peer_gather_u(const Params& p, int layer, int vb, unsigned char* smem) {
    const int lane = TIDX & 63, w = TIDX >> 6, r = vb * 4 + w, g = lane >> 4, sl = lane & 15;
    int* el = (int*)smem + w * 256; float* wl = (float*)(el + 128);
    const GLOBAL_AS unsigned char* U = (const GLOBAL_AS unsigned char*)(p.ufp8 + (size_t)layer * NEXP * D);
    const GLOBAL_AS float* us = (const GLOBAL_AS float*)(p.uscale + layer * NEXP); const GLOBAL_AS float* vs = (const GLOBAL_AS float*)(p.vscale + layer * NEXP);
    WAVE_SYNC();
    const int e0 = L_eidx(p, layer)[(size_t)r * 128 + lane], e1 = L_eidx(p, layer)[(size_t)r * 128 + 64 + lane];
    el[lane] = e0; el[lane + 64] = e1;
    const float g0 = p.gate[(size_t)r * 128 + lane], g1 = p.gate[(size_t)r * 128 + 64 + lane];
    const float us0 = us[e0], us1 = us[e1], vs0 = vs[e0], vs1 = vs[e1];
    f32x2 hreg[32];
#pragma unroll
    for (int it = 0; it < 4; ++it) { const bf16x8 a = *(const bf16x8*)(p.hb + (size_t)r * D + it * 256 + sl * 16), b = *(const bf16x8*)(p.hb + (size_t)r * D + it * 256 + sl * 16 + 8);
#pragma unroll
        for (int m = 0; m < 4; ++m) { hreg[it * 8 + m] = (f32x2){bf2f((bf16_t)a[2 * m]), bf2f((bf16_t)a[2 * m + 1])}; hreg[it * 8 + 4 + m] = (f32x2){bf2f((bf16_t)b[2 * m]), bf2f((bf16_t)b[2 * m + 1])}; } }
    WAVE_SYNC();
    typedef unsigned u32x4 __attribute__((ext_vector_type(4)));
    constexpr int NB = 2;
    u32x4 qa[NB][4], qb[NB][4];
    auto issue = [&](u32x4 (&q)[NB][4], int b) {
#pragma unroll
        for (int i = 0; i < NB; ++i) { const GLOBAL_AS unsigned char* row = U + (size_t)el[(b * NB + i) * 4 + g] * D + sl * 16;
#pragma unroll
            for (int it = 0; it < 4; ++it) q[i][it] = *(const GLOBAL_AS u32x4*)(row + it * 256); } };
    auto consume = [&](const u32x4 (&q)[NB][4], int b) {
#pragma unroll
        for (int i = 0; i < NB; ++i) { f32x2 a0 = {0.f, 0.f}, a1 = {0.f, 0.f};
#pragma unroll
            for (int it = 0; it < 4; ++it)
#pragma unroll
                for (int k = 0; k < 4; ++k) { f32x2 lo, hi; fp8x4_to_f32x2(q[i][it][k], lo, hi); a0 += lo * hreg[it * 8 + k * 2]; a1 += hi * hreg[it * 8 + k * 2 + 1]; }
            float acc = (a0[0] + a1[0]) + (a0[1] + a1[1]);
            acc = red16_sum(acc);
            wl[(b * NB + i) * 4 + g] = acc; } };
    issue(qa, 0);
#pragma unroll 1
    for (int b = 0; b < 32 / NB - 2; b += 2) { issue(qb, b + 1); consume(qa, b); issue(qa, b + 2); consume(qb, b + 1); }
    issue(qb, 32 / NB - 1); consume(qa, 32 / NB - 2); consume(qb, 32 / NB - 1);
    WAVE_SYNC();
    L_wbuf(p, layer)[(size_t)r * 128 + lane] = g0 * gelu_tanh(wl[lane] * us0) * vs0; L_wbuf(p, layer)[(size_t)r * 128 + 64 + lane] = g1 * gelu_tanh(wl[lane + 64] * us1) * vs1;
    WAVE_SYNC();
}
__device__ __forceinline__ void peer_gather_v(const Params& p, int layer, int tok0, int xs, unsigned char* smem, float (&wpre)[8], int (&epre)[8], int tok_next) {
    const int lane = TIDX & 63, w = TIDX >> 6, tq = lane >> 4, sub = (lane >> 3) & 1, pc = lane & 7;
    float* wv = (float*)smem + w * 1024; int* ev = (int*)(wv + 512);
    WAVE_SYNC();
#pragma unroll
    for (int i = 0; i < 8; ++i) { wv[i * 64 + lane] = wpre[i]; ev[i * 64 + lane] = epre[i]; }
    WAVE_SYNC();
    if (tok_next >= 0) {
#pragma unroll
        for (int i = 0; i < 8; ++i) { wpre[i] = L_wbuf(p, layer)[(size_t)tok_next * 128 + i * 64 + lane]; epre[i] = L_eidx(p, layer)[(size_t)tok_next * 128 + i * 64 + lane]; } }
    const GLOBAL_AS unsigned char* V = (const GLOBAL_AS unsigned char*)(p.vfp8 + ((size_t)(layer * 8 + xs) * NEXP) * 128);
    typedef unsigned u32x4 __attribute__((ext_vector_type(4)));
    float o[16];
#pragma unroll
    for (int k = 0; k < 16; ++k) o[k] = 0.f;
    constexpr int GB = 8;
    u32x4 qa[GB], qb[GB];
    auto issue = [&](u32x4 (&q)[GB], int b) {
#pragma unroll
        for (int i = 0; i < GB; ++i) q[i] = *(const GLOBAL_AS u32x4*)(V + (unsigned)(ev[tq * 128 + (b * GB + i) * 2 + sub] * 128 + pc * 16)); };
    auto consume = [&](const u32x4 (&q)[GB], int b) {
#pragma unroll
        for (int i = 0; i < GB; ++i) { const float wj = wv[tq * 128 + (b * GB + i) * 2 + sub];
#pragma unroll
            for (int k = 0; k < 4; ++k) { float f[4]; fp8x4_to_f32(q[i][k], f); o[k * 4] += wj * f[0]; o[k * 4 + 1] += wj * f[1]; o[k * 4 + 2] += wj * f[2]; o[k * 4 + 3] += wj * f[3]; } } };
    issue(qa, 0);
#pragma unroll 1
    for (int b = 0; b < 64 / GB - 2; b += 2) { issue(qb, b + 1); consume(qa, b); issue(qa, b + 2); consume(qb, b + 1); }
    issue(qb, 64 / GB - 1); consume(qa, 64 / GB - 2); consume(qb, 64 / GB - 1);
#pragma unroll
    for (int k = 0; k < 16; ++k) o[k] += shx8(o[k]);
    if (sub == 0) { bf16x8 a, b;
#pragma unroll
        for (int k = 0; k < 8; ++k) { a[k] = (short)f2bf(o[k]); b[k] = (short)f2bf(o[8 + k]); }
        bf16_t* dst = L_po(p, layer) + (size_t)(tok0 + tq) * D + xs * 128 + pc * 16; *(bf16x8*)dst = a; *(bf16x8*)(dst + 8) = b; }
}
__device__ __forceinline__ void phase_final(const Params& p, int layer, int vb) {
    const int lane = TIDX & 63, r = vb * 4 + (TIDX >> 6);
    const float* g2 = mod_ptr(p, layer, mod_row(p, r), 5); const bf16_t* po = L_po(p, layer) + (size_t)r * D; float* xr = p.out + (size_t)r * D;
#pragma unroll
    for (int i = 0; i < 4; ++i) { const int c0 = i * 256 + lane * 4; f32x4 v = *(f32x4*)(xr + c0); const bf16x4 pv = *(const bf16x4*)(po + c0);
#pragma unroll
        for (int j = 0; j < 4; ++j) v[j] += g2[c0 + j] * bf2f((bf16_t)pv[j]);
        *(f32x4*)(xr + c0) = v; }
}

enum { PH_PROLOGUE = 0, PH_NORM1, PH_GEMM_IN, PH_POST, PH_MIXA, PH_MIXB, PH_MIXC, PH_GLU, PH_GEMM_OUT, PH_NORM2, PH_GEMM_PQ, PH_SCORE, PH_GATHER, PH_GV, PH_COUNT, PH_FINAL };
struct Sched { int xidx, NX, rank, nloc; };
__device__ __forceinline__ int rows_out(const Params& p, int layer) { return layer == 0 ? p.NT : p.NTOK; }
template <class F> __device__ __forceinline__ void for_rowblocks(const Sched& sc, int nrb, int nsub, F f) {
    const int tot = ((nrb + sc.NX - 1) / sc.NX) * nsub;
    for (int j = sc.rank; j < tot; j += sc.nloc) { const int rb = (j / nsub) * sc.NX + sc.xidx; if (rb < nrb) f(rb * nsub + j % nsub); }
}
template <class F> __device__ __forceinline__ void for_items(int n, F f) { for (int vb = blockIdx.x; vb < n; vb += gridDim.x) f(vb); }
template <int ph> __device__ __forceinline__ void run_phase(const Params& p, const Sched& sc, int layer, unsigned char* smem, int sub = -1) {
    const int NCH = p.NT / 128, RO = rows_out(p, layer) / 128;
#ifdef DUP_PH
#pragma unroll 1
    for (int dup = 0; dup < (ph == DUP_PH ? 2 : 1); ++dup)
#endif
    if constexpr (ph == PH_PROLOGUE) for_items(prologue_items(p), [&](int vb) { phase_prologue(p, vb, smem); });
    else if constexpr (ph == PH_NORM1) for_rowblocks(sc, NCH, 16, [&](int vb) { phase_norm<0>(p, layer, vb, p.NT); });
    else if constexpr (ph == PH_GEMM_IN) for_rowblocks(sc, NCH, PROJ / 128, [&](int vb) { EpiIn e{&p, layer}; gemm_tile(p.hb, D, p.wt_in + (size_t)layer * D * PROJ, D, D, (vb / (PROJ / 128)) * 128, (vb % (PROJ / 128)) * 128, smem, e); });
    else if constexpr (ph == PH_POST) { }
    else if constexpr (ph == PH_MIXA) {
        if (sub == 0) for_rowblocks(sc, RO, 8, [&](int vb) { const int h = vb & 7, qblk = vb >> 3, row0 = qblk * 128; const bool lat = row0 < p.NTOK;
            const int b = lat ? qblk / p.NLC : (qblk - p.NTOK / 128) / p.NCC, qb = lat ? qblk % p.NLC : -1; attn_item(p, layer, row0, b, qb, h, smem); });
        if (sub == 1) for_rowblocks(sc, NCH, 8, [&](int vb) { s5_phaseA(p, layer, vb, smem); });
        if (sub == 2) for_rowblocks(sc, NCH, 4, [&](int vb) { ret_phaseA(p, layer, vb, smem); });
    }
    else if constexpr (ph == PH_MIXB) for_items((p.B * 2 * 16 * 64) / 256 + (p.B * 4 * 2 * 4096) / 256, [&](int vb) { const int n5 = (p.B * 2 * 16 * 64) / 256; if (vb < n5) s5_phaseB(p, layer, vb); else ret_phaseB(p, layer, vb - n5); });
    else if constexpr (ph == PH_MIXC) { if (sub == 0) for_rowblocks(sc, RO, 4, [&](int vb) { s5_phaseC(p, layer, vb, smem); }); if (sub == 1) for_rowblocks(sc, RO, 4, [&](int vb) { ret_phaseC(p, layer, vb, smem); }); }
    else if constexpr (ph == PH_GLU) for_rowblocks(sc, RO, 2, [&](int vb) { EpiGlu e{p.yg, p.mix, p.s5_glu_b + layer * 256}; gemm_tile(p.yg, 256, p.wt_glu + (size_t)layer * 256 * 256, 256, 256, (vb >> 1) * 128, (vb & 1) * 128, smem, e); });
    else if constexpr (ph == PH_GEMM_OUT) for_rowblocks(sc, RO, 8, [&](int vb) { EpiResidual e = make_epi_residual(p, layer); gemm_tile(p.mix, D, p.wt_out + (size_t)layer * D * D, D, D, (vb >> 3) * 128, (vb & 7) * 128, smem, e); });
    else if constexpr (ph == PH_NORM2) for_rowblocks(sc, RO, 16, [&](int vb) { phase_norm<1>(p, layer, vb, rows_out(p, layer)); });
    else if constexpr (ph == PH_GEMM_PQ) for_rowblocks(sc, RO, 8, [&](int vb) { EpiStoreBf16 e{p.pqb, D}; gemm_tile(p.hb, D, p.wt_pq + (size_t)layer * D * D, D, D, (vb >> 3) * 128, (vb & 7) * 128, smem, e); });
    else if constexpr (ph == PH_SCORE) for_rowblocks(sc, RO, 8, [&](int vb) { peer_score(p, layer, vb, smem); });
    else if constexpr (ph == PH_GATHER) for_rowblocks(sc, RO, 32, [&](int vb) { peer_gather_u(p, layer, vb, smem); });
    else if constexpr (ph == PH_GV) {
        const int ntok = RO * 128, w = TIDX >> 6;
        const int lane = TIDX & 63; float wpre[8]; int epre[8];
        for (int xs = sc.xidx; xs < 8; xs += sc.NX) { const int t0 = (sc.rank * 4 + w) * 4;
            if (t0 < ntok) {
#pragma unroll
                for (int i = 0; i < 8; ++i) { wpre[i] = L_wbuf(p, layer)[(size_t)t0 * 128 + i * 64 + lane]; epre[i] = L_eidx(p, layer)[(size_t)t0 * 128 + i * 64 + lane]; } }
            for (int t = t0; t < ntok; t += sc.nloc * 16) { const int tn = t + sc.nloc * 16; peer_gather_v(p, layer, t, xs, smem, wpre, epre, tn < ntok ? tn : -1); } }
    }
    else if constexpr (ph == PH_FINAL) for_rowblocks(sc, p.NTOK / 128, 32, [&](int vb) { phase_final(p, layer, vb); });
}

#ifdef CPU_EMU
#define DECL_SMEM unsigned char* smem = EMU_DYN_SMEM()
#else
#define DECL_SMEM extern __shared__ __attribute__((aligned(16))) unsigned char smem[]
#endif

template <int ph> __global__ void __launch_bounds__(NTHREADS, 2) k_phase(Params p, int layer) {
    DECL_SMEM;
    Sched sc; sc.xidx = 0; sc.NX = 1; sc.rank = blockIdx.x; sc.nloc = gridDim.x;
    for (int sub = 0; sub < 3; ++sub) { if (sub == 0 || ph == PH_MIXA || (ph == PH_MIXC && sub < 2)) run_phase<ph>(p, sc, layer, smem, sub); }
}

#ifdef CPU_EMU
#define GRID_SYNC() do { (void)nsync; emu::grid_sync(); } while (0)
#define XCD_SYNC() GRID_SYNC()
#define OPAQUE_S(x)
#else
#define XB_TMO      128
#define XB_XCNT(j)  (256  + 64 * (j))
#define XB_XSUB(j)  (1280 + 64 * (j))
#define XB_XGEN(j)  (2304 + 64 * (j))
#define XB_TOP      3328
#define XB_TOPGEN   3392
#define XCD_BAR_WORDS 3456
#define XB_SPIN_CAP (1u << 18)
#define LAS __attribute__((address_space(3)))

__device__ __forceinline__ unsigned xb_ld(unsigned* p)              { return __hip_atomic_load(p, __ATOMIC_RELAXED, __HIP_MEMORY_SCOPE_AGENT); }
__device__ __forceinline__ unsigned xb_add(unsigned* p, unsigned v) { return __hip_atomic_fetch_add(p, v, __ATOMIC_RELAXED, __HIP_MEMORY_SCOPE_AGENT); }
__device__ __forceinline__ unsigned xb_xcc_id() { return (unsigned)__builtin_amdgcn_s_getreg((3 << 11) | 20) & 0xFu; }
#define XB_SPIN(cond, bar) do { unsigned _sp = 0; while (cond) { __builtin_amdgcn_s_sleep(1); \
    if ((++_sp & 255u) == 0u) { if (xb_ld(&(bar)[XB_TMO])) break; if (_sp > XB_SPIN_CAP) { atomicAdd(&(bar)[XB_TMO], 1u); break; } } } } while (0)

struct XcdBarrier {
    unsigned* bar; unsigned x;
    volatile LAS unsigned* st;
};

__device__ __forceinline__ XcdBarrier xcd_barrier_post(unsigned* bar, volatile LAS unsigned* st) {
    XcdBarrier b; b.bar = bar; b.x = xb_xcc_id(); b.st = st;
    if (threadIdx.x == 0) (void)xb_add(&bar[XB_XCNT(b.x)], 1u);
    return b;
}
__device__ __forceinline__ void xcd_barrier_complete(unsigned* bar, unsigned x, unsigned& nloc, unsigned& nx) {
    const unsigned G = gridDim.x * gridDim.y * gridDim.z;
    unsigned sum, cnt, mine, sp = 0u;
    for (;;) {
        sum = 0u; cnt = 0u; mine = 0u;
#pragma unroll
        for (unsigned j = 0; j < 16; ++j) { const unsigned c = xb_ld(&bar[XB_XCNT(j)]); sum += c; cnt += (c > 0u) ? 1u : 0u; mine = (j == x) ? c : mine; }
        if (sum == G) break;
        __builtin_amdgcn_s_sleep(1);
        if ((++sp & 255u) == 0u) { if (xb_ld(&bar[XB_TMO])) break; if (sp > XB_SPIN_CAP) { atomicAdd(&bar[XB_TMO], 1u); break; } }
    }
    nloc = mine > 0u ? mine : 1u; nx = cnt > 0u ? cnt : 1u;
}

template <bool LOCAL> __device__ __forceinline__ void xcd_barrier(const XcdBarrier& b) {
    asm volatile("s_waitcnt vmcnt(0)" ::: "memory");
    __syncthreads();
    if (threadIdx.x == 0) {
        unsigned* bar = b.bar;
        __builtin_amdgcn_s_waitcnt(0);
        unsigned nloc = b.st[0], nx = b.st[1];
        if (nloc == 0u) { xcd_barrier_complete(bar, b.x, nloc, nx); b.st[0] = nloc; b.st[1] = nx; }
        const unsigned old = xb_add(&bar[XB_XSUB(b.x)], 1u);
        const unsigned gen = old / nloc;
        if (old + 1u == (gen + 1u) * nloc) {
            if constexpr (!LOCAL) {
            __builtin_amdgcn_fence(__ATOMIC_RELEASE, "agent");
            asm volatile("s_waitcnt vmcnt(0)" ::: "memory");
            const unsigned og = xb_add(&bar[XB_TOP], 1u);
            const unsigned tg = og / nx;
            if (og + 1u == (tg + 1u) * nx) xb_add(&bar[XB_TOPGEN], 1u);
            else XB_SPIN(xb_ld(&bar[XB_TOPGEN]) == tg, bar);
            }
            __builtin_amdgcn_fence(__ATOMIC_ACQUIRE, "agent");
            xb_add(&bar[XB_XGEN(b.x)], 1u);
            asm volatile("s_waitcnt vmcnt(0)" ::: "memory");
        } else {
            XB_SPIN(xb_ld(&bar[XB_XGEN(b.x)]) == gen, bar);
            __builtin_amdgcn_fence(__ATOMIC_ACQUIRE, "agent");
            asm volatile("s_waitcnt vmcnt(0)" ::: "memory");
        }
    }
    __syncthreads();
}

#define GRID_SYNC() do { XcdBarrier b_; b_.bar = p.bar + 2048; b_.x = (unsigned)scw[0]; b_.st = (volatile LAS unsigned*)(smem + SCHED_OFF + 64); xcd_barrier<false>(b_); } while (0)
#define XCD_SYNC() do { XcdBarrier b_; b_.bar = p.bar + 2048; b_.x = (unsigned)scw[0]; b_.st = (volatile LAS unsigned*)(smem + SCHED_OFF + 64); xcd_barrier<true>(b_); } while (0)
#define OPAQUE_S(x) do { asm volatile("" : "+v"(x)); x = __builtin_amdgcn_readfirstlane(x); } while (0)
#endif
#ifndef ONE_PER_CU_MASK
#define ONE_PER_CU_MASK 0
#endif
constexpr int PARAMS_OFF = 66560;
constexpr int SCHED_OFF = PARAMS_OFF + 1024;
static_assert(PARAMS_OFF + sizeof(Params) <= SCHED_OFF && SCHED_OFF + 128 <= LDS_BYTES, "Params copy must fit");
__global__ void __launch_bounds__(NTHREADS, 2) k_mega(Params p_arg) {
    DECL_SMEM;
    if (threadIdx.x == 0) *(Params*)(smem + PARAMS_OFF) = p_arg;
    __syncthreads();
    const Params& p = *(const Params*)(smem + PARAMS_OFF);
    volatile int* scw = (volatile int*)(smem + SCHED_OFF);
#ifndef CPU_EMU
    volatile LAS unsigned* xb_st = (volatile LAS unsigned*)(smem + SCHED_OFF + 64);
    if (threadIdx.x == 0) { xb_st[0] = 0u; xb_st[1] = 0u; xb_st[2] = 0u; xb_st[3] = 0u; }
    __syncthreads();
    (void)xcd_barrier_post(p.bar + 2048, xb_st);
#else
    unsigned nsync = 0u;
#endif
    if (threadIdx.x == 0) {
#ifdef CPU_EMU
        const unsigned xcc = blockIdx.x % 8u;
        const unsigned rank = atomicAdd(p.bar + 64 + xcc, 1u);
#else
        const unsigned xcc = (unsigned)__builtin_amdgcn_s_getreg((3 << 11) | 20) & 0xFu;
        const unsigned rank = __hip_atomic_fetch_add(p.bar + 64 + xcc, 1u, __ATOMIC_RELAXED, __HIP_MEMORY_SCOPE_AGENT);
#endif
        scw[0] = (int)xcc; scw[1] = (int)rank;
#ifndef CPU_EMU
        const unsigned hw = (unsigned)__builtin_amdgcn_s_getreg(((8 - 1) << 11) | (8 << 6) | 4);
        const unsigned curank = __hip_atomic_fetch_add(p.bar + 128 + ((xcc << 8) | (hw & 0xFFu)), 1u, __ATOMIC_RELAXED, __HIP_MEMORY_SCOPE_AGENT);
        unsigned arank = 0xFFFFu; if (curank == 0u) arank = __hip_atomic_fetch_add(p.bar + 96 + xcc, 1u, __ATOMIC_RELAXED, __HIP_MEMORY_SCOPE_AGENT);
        scw[5] = (int)curank; scw[6] = (int)arank; scw[8] = (int)((xcc << 8) | (hw & 0xFFu));
        if (curank == 0u) __hip_atomic_store(p.bar + 5632 + ((xcc << 8) | (hw & 0xFFu)), arank, __ATOMIC_RELAXED, __HIP_MEMORY_SCOPE_AGENT);
#else
        scw[5] = 0; scw[6] = (int)rank;
#endif
    }
#ifdef CPU_EMU
    emu::grid_sync();
#else
    asm volatile("s_waitcnt vmcnt(0)" ::: "memory");
    cooperative_groups::this_grid().sync();
#endif
    if (threadIdx.x == 0) {
        const int xcc = scw[0]; int nx = 0, xi = 0, nl = 1;
        for (int j = 0; j < 16; ++j) {
#ifdef CPU_EMU
            const unsigned c = p.bar[64 + j];
#else
            const unsigned c = __hip_atomic_load(p.bar + 64 + j, __ATOMIC_RELAXED, __HIP_MEMORY_SCOPE_AGENT);
#endif
            if (c) { if (j < xcc) ++xi; ++nx; } if (j == xcc) nl = (int)c; }
        scw[2] = xi; scw[3] = nx; scw[4] = nl;
#ifndef CPU_EMU
        scw[7] = (int)__hip_atomic_load(p.bar + 96 + xcc, __ATOMIC_RELAXED, __HIP_MEMORY_SCOPE_AGENT);
        if (scw[7] * 2 == nl && scw[5] < 2) { const int cidx = scw[5] == 0 ? scw[6] : (int)__hip_atomic_load(p.bar + 5632 + scw[8], __ATOMIC_RELAXED, __HIP_MEMORY_SCOPE_AGENT);
            if (cidx >= 0 && cidx < scw[7]) scw[1] = cidx + scw[7] * scw[5]; }
#else
        scw[7] = nl;
#endif
    }
    __syncthreads();
    { Sched sc; sc.xidx = UNIFORM(scw[2]); sc.NX = UNIFORM(scw[3]); sc.rank = UNIFORM(scw[1]); sc.nloc = UNIFORM(scw[4]); run_phase<PH_PROLOGUE>(p, sc, 0, smem); GRID_SYNC(); }
    for (int step = 1; step < 1 + 2 * (PH_COUNT - 1); ++step) {
        int ph = 1 + (step - 1) % (PH_COUNT - 1), layer = (step - 1) / (PH_COUNT - 1);
        if (ph == PH_POST) continue;
        OPAQUE_S(ph); OPAQUE_S(layer);
        Sched sc; sc.xidx = UNIFORM(scw[2]); sc.NX = UNIFORM(scw[3]); sc.rank = UNIFORM(scw[1]); sc.nloc = UNIFORM(scw[4]);
        if ((ONE_PER_CU_MASK >> ph) & 1) {
            if (scw[5] != 0) { GRID_SYNC(); continue; }
            sc.rank = scw[6]; sc.nloc = scw[7];
        }
        switch (ph) {
            case PH_NORM1: run_phase<PH_NORM1>(p, sc, layer, smem); break;
            case PH_GEMM_IN: run_phase<PH_GEMM_IN>(p, sc, layer, smem); break;
            case PH_POST: run_phase<PH_POST>(p, sc, layer, smem); break;
            case PH_MIXA: run_phase<PH_MIXA>(p, sc, layer, smem, 0); XCD_SYNC(); run_phase<PH_MIXA>(p, sc, layer, smem, 1); XCD_SYNC(); run_phase<PH_MIXA>(p, sc, layer, smem, 2); break;
            case PH_MIXB: run_phase<PH_MIXB>(p, sc, layer, smem); break;
            case PH_MIXC: run_phase<PH_MIXC>(p, sc, layer, smem, 0); XCD_SYNC(); run_phase<PH_MIXC>(p, sc, layer, smem, 1); break;
            case PH_GLU: run_phase<PH_GLU>(p, sc, layer, smem); break;
            case PH_GEMM_OUT: run_phase<PH_GEMM_OUT>(p, sc, layer, smem); break;
            case PH_NORM2: run_phase<PH_NORM2>(p, sc, layer, smem); break;
            case PH_GEMM_PQ: run_phase<PH_GEMM_PQ>(p, sc, layer, smem); break;
            case PH_SCORE: run_phase<PH_SCORE>(p, sc, layer, smem); break;
            case PH_GATHER: run_phase<PH_GATHER>(p, sc, layer, smem); break;
            default: run_phase<PH_GV>(p, sc, layer, smem); break;
        }
        if (ph == PH_NORM1 || ph == PH_MIXC || ph == PH_GLU || ph == PH_GEMM_OUT || ph == PH_NORM2 || ph == PH_GEMM_PQ || ph == PH_SCORE) XCD_SYNC(); else GRID_SYNC();
    }
    { Sched sc; sc.xidx = UNIFORM(scw[2]); sc.NX = UNIFORM(scw[3]); sc.rank = UNIFORM(scw[1]); sc.nloc = UNIFORM(scw[4]); run_phase<PH_FINAL>(p, sc, 1, smem); }
}

#ifdef CPU_EMU
extern "C" void emu_check(const char* name, const float* data, long rows, long cols, long ld);
extern "C" void emu_check2(const char* name, const float* data, long rows, long cols, long ld, long rcols, long rcol0);
static void emu_check_bf16(const char* name, const bf16_t* d, long rows, long cols, long ld, long col0, long rcols) {
    float* t = (float*)malloc(rows * cols * 4); for (long r = 0; r < rows; ++r) for (long c = 0; c < cols; ++c) t[r * cols + c] = bf2f(d[r * ld + col0 + c]);
    emu_check2(name, t, rows, cols, cols, rcols, col0); free(t);
}
#endif

static size_t carve(size_t& off, size_t bytes) { size_t o = off; off += (bytes + 255) / 256 * 256; return o; }

extern "C" void kernel_launch(void* const* d_in, const int* in_sizes, int n_in, void* d_out, int out_size, void* d_ws, size_t ws_size, hipStream_t stream) {
    Params p{};
    const float** fp = (const float**)&p.x;
    for (int i = 0; i < 28; ++i) fp[i] = (const float*)d_in[i];
    p.out = (float*)d_out;
    p.B = in_sizes[1] / D; p.SEQ = in_sizes[0] / (p.B * D); p.CTX = in_sizes[2] / (p.B * D);
    p.NTOK = p.B * p.SEQ; p.NCTX = p.B * p.CTX; p.NT = p.NTOK + p.NCTX; p.NLC = p.SEQ / 128; p.NCC = p.CTX / 128;
    char* ws = (char*)d_ws; size_t off = 0; const size_t NT = p.NT, NCH = NT / 128;
    p.mod = (float*)(ws + carve(off, 2 * (p.B + 1) * NMOD * D * 4));
    p.ropeA = (float*)(ws + carve(off, (size_t)p.SEQ * 64 * 4)); p.ropeR = (float*)(ws + carve(off, (size_t)p.SEQ * 64 * 4));
    p.wt_in = (bf16_t*)(ws + carve(off, 2ull * D * PROJ * 2)); p.wt_out = (bf16_t*)(ws + carve(off, 2ull * D * D * 2));
    p.wt_pq = (bf16_t*)(ws + carve(off, 2ull * D * D * 2)); p.wt_glu = (bf16_t*)(ws + carve(off, 2ull * 256 * 256 * 2));
    p.hb = (bf16_t*)(ws + carve(off, NT * D * 2)); p.mix = (bf16_t*)(ws + carve(off, NT * D * 2)); p.yg = (bf16_t*)(ws + carve(off, NT * 256 * 2));
    p.zb = (bf16_t*)(ws + carve(off, NT * PROJ * 2));
    p.pqb = (bf16_t*)(ws + carve(off, NT * D * 2)); p.kb16 = (bf16_t*)(ws + carve(off, 2 * 2 * 8 * 128 * 64 * 2));
    p.ufp8 = (unsigned char*)(ws + carve(off, 2ull * NEXP * D)); p.vfp8 = (unsigned char*)(ws + carve(off, 2ull * NEXP * D));
    p.s5_pt = (bf16_t*)(ws + carve(off, 64ull * 128 * 128 * 2)); p.s5_bc = (float*)(ws + carve(off, 64ull * 64 * 16 * 2 * 4)); p.s5_ab = (float*)(ws + carve(off, 64ull * 64 * 4 * 4)); p.s5_cm = (bf16_t*)(ws + carve(off, 64ull * 16 * 128 * 2));
    p.uscale = (float*)(ws + carve(off, 2 * NEXP * 4)); p.vscale = (float*)(ws + carve(off, 2 * NEXP * 4));
    p.ctxs = (float*)(ws + carve(off, (size_t)p.NCTX * D * 4));
    p.s5_hend = (float*)(ws + carve(off, 2 * NCH * 4096 * 4)); p.s5_hin = (float*)(ws + carve(off, 2 * NCH * 4096 * 4));
    p.ret_kv = (float*)(ws + carve(off, 2 * NCH * 32768 * 4)); p.ret_sin = (float*)(ws + carve(off, 2 * NCH * 32768 * 4));
    p.akv = (bf16_t*)(ws + carve(off, 2 * NT * 256 * 2)); p.bar = (unsigned*)(ws + carve(off, 32768));
    p.ytmp = (float*)(bf16_t*)p.pqb;     p.gate = (float*)(ws + carve(off, NT * 128 * 4)); p.eidx = (int*)(ws + carve(off, 2 * NT * 128 * 4));
    p.wbuf = (float*)(ws + carve(off, 2 * NT * 128 * 4)); p.avt = (bf16_t*)(ws + carve(off, 2 * NT * 128 * 2)); p.po = (bf16_t*)(ws + carve(off, 2 * NT * D * 2));
    if (off > ws_size) { fprintf(stderr, "workspace too small: need %zu have %zu\n", off, ws_size); return; }
#if MEGA
#ifdef CPU_EMU
    memset(p.bar, 0, 32768);
    EMU_LAUNCH_COOP(k_mega, 16, NTHREADS, LDS_BYTES, stream, p);
#else
    static int grid_blocks = 0;
    if (!grid_blocks) {
        int dev = 0, cus = 0, per_cu = 0;
        (void)hipGetDevice(&dev); (void)hipDeviceGetAttribute(&cus, hipDeviceAttributeMultiprocessorCount, dev);
        (void)hipFuncSetAttribute((const void*)k_mega, hipFuncAttributeMaxDynamicSharedMemorySize, LDS_BYTES);
        (void)hipOccupancyMaxActiveBlocksPerMultiprocessor(&per_cu, (const void*)k_mega, NTHREADS, LDS_BYTES);
        if (per_cu > 2) per_cu = 2;
        grid_blocks = cus * per_cu;
    }
    (void)hipMemsetAsync(p.bar, 0, 32768, stream);
    void* args[] = {&p};
    hipError_t e = hipLaunchCooperativeKernel((const void*)k_mega, dim3(grid_blocks), dim3(NTHREADS), args, LDS_BYTES, stream);
    if (e != hipSuccess) fprintf(stderr, "cooperative launch failed: %s (grid %d)\n", hipGetErrorString(e), grid_blocks);
#endif
#else
#ifdef CPU_EMU
    const int grid = 64;
#define RUN(ph, layer) EMU_LAUNCH(k_phase<ph>, grid, NTHREADS, LDS_BYTES, stream, p, layer)
#else
    const int grid = 512;
#define RUN(ph, layer) do { (void)hipFuncSetAttribute((const void*)k_phase<ph>, hipFuncAttributeMaxDynamicSharedMemorySize, LDS_BYTES); hipLaunchKernelGGL(k_phase<ph>, dim3(grid), dim3(NTHREADS), LDS_BYTES, stream, p, layer); } while (0)
#endif
    RUN(PH_PROLOGUE, 0);
#ifdef CPU_EMU
    emu_check("mod0", p.mod, p.B + 1, NMOD * D, NMOD * D);
#define CHK(code) if (layer == 0) { code; }
#else
#define CHK(code)
#endif
    for (int layer = 0; layer < 2; ++layer) {
        RUN(PH_NORM1, layer);
#ifdef CPU_EMU
        if (layer == 1) { emu_check("x2_0", p.out, p.NTOK, D, D); emu_check("ctx2_0", p.ctxs, p.NCTX, D, D); }
#endif
        RUN(PH_GEMM_IN, layer);
        RUN(PH_MIXA, layer); CHK(emu_check_bf16("mix0", p.mix, NT, 512, D, 0, D))
        RUN(PH_MIXB, layer);
        RUN(PH_MIXC, layer); CHK(emu_check_bf16("mix0", p.mix, NT, 256, D, 768, D))
        RUN(PH_GLU, layer); CHK(emu_check_bf16("mix0", p.mix, NT, 256, D, 512, D))
        RUN(PH_GEMM_OUT, layer); CHK(emu_check("x1_0", p.out, p.NTOK, D, D))
        RUN(PH_NORM2, layer); CHK(emu_check_bf16("h2_0", p.hb, p.NTOK, D, D, 0, D))
        RUN(PH_GEMM_PQ, layer);
        RUN(PH_SCORE, layer); CHK(float* t = (float*)malloc(NT * 128 * 4); for (size_t i = 0; i < (size_t)p.NTOK * 128; ++i) t[i] = (float)p.eidx[i]; emu_check("eidx0", t, p.NTOK, 128, 128); free(t); emu_check("gate0", p.gate, p.NTOK, 128, 128))
        RUN(PH_GATHER, layer); RUN(PH_GV, layer);
    }
    RUN(PH_FINAL, 1);
#endif
}
```

```cpp
#ifndef CPU_EMU
#include <hip/hip_runtime.h>
#include <hip/hip_cooperative_groups.h>
#endif
#include <cstdio>
#include <cstdint>
#include <cmath>

#ifndef MEGA
#define MEGA 1
#endif

typedef unsigned short bf16_t;
typedef short bf16x8 __attribute__((ext_vector_type(8)));
typedef short bf16x4 __attribute__((ext_vector_type(4)));
typedef float f32x4 __attribute__((ext_vector_type(4)));
typedef float f32x16 __attribute__((ext_vector_type(16)));
typedef unsigned long long u64;

constexpr int D = 1024, PROJ = 2048, NMOD = 6;
constexpr int NEXP = 16384;
constexpr int NTHREADS = 256;
constexpr int LDS_BYTES = 68608;
constexpr float EPS = 1e-6f;
constexpr int ZQ = 0, ZK = 512, ZV = 640, ZSU = 768, ZRQ = 1024, ZRK = 1280, ZRV = 1536, ZRG = 1792;

#ifdef CPU_EMU
#define GP_AS
#else
#define GP_AS __attribute__((address_space(1)))
#endif
template <class T> struct GP {
    GP_AS T* raw;
    __host__ __device__ __forceinline__ operator T*() const { return (T*)raw; }
    __host__ __device__ __forceinline__ GP& operator=(T* q) { raw = (GP_AS T*)q; return *this; }
};
struct Params {
    GP<const float> x, c, ctx, c_ctx, ada_w, ada_b, norm1_w, norm2_w, w_in, w_out, q_norm_w, k_norm_w, attn_sink,
        s5_a_re, s5_a_im, s5_log_dt, s5_b_re, s5_b_im, s5_c_re, s5_c_im, s5_d, s5_glu_w, s5_glu_b, ret_decay,
        peer_wq, peer_keys, peer_u, peer_v;
    GP<float> out;
    GP<float> mod, ropeA, ropeR, ctxs, s5_hend, s5_hin, ret_kv, ret_sin, gate, ytmp, wbuf;
    GP<bf16_t> wt_in, wt_out, wt_pq, wt_glu, hb, mix, yg, pqb, kb16, zb, akv, po, avt;
    GP<int> eidx; GP<unsigned> bar; GP<unsigned char> ufp8, vfp8; GP<float> uscale, vscale; GP<bf16_t> s5_pt, s5_cm, s5_bcb; GP<float> s5_bc, s5_ab;
    int B, SEQ, CTX, NTOK, NCTX, NT, NLC, NCC;
};

#ifdef CPU_EMU
#define GLOBAL_AS
#else
#define GLOBAL_AS __attribute__((address_space(1)))
#endif
#ifdef CPU_EMU
#define WAVE_SYNC() emu::wave_sync()
#else
#define WAVE_SYNC() do { __builtin_amdgcn_fence(__ATOMIC_RELEASE, "wavefront"); __builtin_amdgcn_wave_barrier(); __builtin_amdgcn_fence(__ATOMIC_ACQUIRE, "wavefront"); } while (0)
#endif
#ifdef CPU_EMU
#define OPAQUE_V(x)
#else
#define OPAQUE_V(x) asm volatile("" : "+v"(x))
#endif
#ifdef CPU_EMU
#define EXP2(x) exp2f(x)
#else
#define EXP2(x) __builtin_amdgcn_exp2f(x)
#endif
#ifdef CPU_EMU
#define UNIFORM(x) (x)
#else
#define UNIFORM(x) __builtin_amdgcn_readfirstlane(x)
#endif
#ifdef CPU_EMU
#define TIDX ((int)threadIdx.x)
#else
__device__ __forceinline__ int tidx_opaque() { int t = threadIdx.x; asm volatile("" : "+v"(t)); return t; }
#define TIDX tidx_opaque()
#endif
__device__ __forceinline__ unsigned f2u(float f) { unsigned u; __builtin_memcpy(&u, &f, 4); return u; }
__device__ __forceinline__ float u2f(unsigned u) { float f; __builtin_memcpy(&f, &u, 4); return f; }
#ifdef CPU_EMU
__device__ __forceinline__ bf16_t f2bf(float f) { unsigned u = f2u(f); u += 0x7fffu + ((u >> 16) & 1u); return (bf16_t)(u >> 16); }
#else
__device__ __forceinline__ bf16_t f2bf(float f) { return __builtin_bit_cast(unsigned short, (__bf16)f); }
#endif
__device__ __forceinline__ float bf2f(bf16_t h) { return u2f(((unsigned)h) << 16); }
__device__ __forceinline__ float gelu_tanh(float x) { const float k = 0.7978845608028654f; float t = k * (x + 0.044715f * x * x * x); return x / (1.f + __expf(-2.f * t)); }
__device__ __forceinline__ float sigmoidf_(float x) { return 1.f / (1.f + __expf(-x)); }
__device__ __forceinline__ float siluf_(float x) { return x / (1.f + __expf(-x)); }
#ifdef CPU_EMU
__device__ __forceinline__ float red16_sum(float v) { v += __shfl_xor(v, 1); v += __shfl_xor(v, 2); v += __shfl_xor(v, 4); v += __shfl_xor(v, 8); return v; }
__device__ __forceinline__ float shx8(float v) { return __shfl_xor(v, 8); }
#else
template <int CTRL> __device__ __forceinline__ float dpp_mov(float v) { return __int_as_float(__builtin_amdgcn_update_dpp(0, __float_as_int(v), CTRL, 0xF, 0xF, false)); }
__device__ __forceinline__ float red16_sum(float v) { v += dpp_mov<0xB1>(v); v += dpp_mov<0x4E>(v); v += dpp_mov<0x141>(v); v += dpp_mov<0x140>(v); return v; }
__device__ __forceinline__ float shx8(float v) { return dpp_mov<0x128>(v); }
#endif
__device__ __forceinline__ float wave_sum(float v) { for (int m = 32; m >= 1; m >>= 1) v += __shfl_xor(v, m); return v; }
__device__ __forceinline__ int mod_row(const Params& p, int r) { return r < p.NTOK ? r / p.SEQ : p.B; }
__device__ __forceinline__ const float* mod_ptr(const Params& p, int layer, int mrow, int which) { return p.mod + ((size_t)(layer * (p.B + 1) + mrow) * NMOD + which) * D; }
__device__ __forceinline__ const float* xsrc_row(const Params& p, int layer, int r) {
    if (layer == 0) return r < p.NTOK ? p.x + (size_t)r * D : p.ctx + (size_t)(r - p.NTOK) * D;
    return r < p.NTOK ? p.out + (size_t)r * D : p.ctxs + (size_t)(r - p.NTOK) * D;
}
__device__ __forceinline__ float* xdst_row(const Params& p, int r) { return r < p.NTOK ? p.out + (size_t)r * D : p.ctxs + (size_t)(r - p.NTOK) * D; }
__device__ __forceinline__ bool chunk_is_ctx(const Params& p, int gc) { return gc >= p.NTOK / 128; }
__device__ __forceinline__ int order_chunk(const Params& p, int b, int dir, int pos) {
    if (pos < p.NCC) { int j = dir ? (p.NCC - 1 - pos) : pos; return p.NTOK / 128 + b * p.NCC + j; }
    int j = pos - p.NCC; if (dir) j = p.NLC - 1 - j; return b * p.NLC + j;
}

__device__ __forceinline__ float* L_hend(const Params& p, int layer) { return p.s5_hend + (size_t)layer * (p.NT / 128) * 4096; }
__device__ __forceinline__ float* L_hin(const Params& p, int layer) { return p.s5_hin + (size_t)layer * (p.NT / 128) * 4096; }
__device__ __forceinline__ float* L_kv(const Params& p, int layer) { return p.ret_kv + (size_t)layer * (p.NT / 128) * 32768; }
__device__ __forceinline__ float* L_sin(const Params& p, int layer) { return p.ret_sin + (size_t)layer * (p.NT / 128) * 32768; }
__device__ __forceinline__ int* L_eidx(const Params& p, int layer) { return p.eidx + (size_t)layer * p.NT * 128; }
__device__ __forceinline__ float* L_wbuf(const Params& p, int layer) { return p.wbuf + (size_t)layer * p.NT * 128; }
__device__ __forceinline__ bf16_t* L_po(const Params& p, int layer) { return p.po + (size_t)layer * p.NT * D; }
__device__ __forceinline__ bf16_t* L_akv(const Params& p, int layer) { return p.akv + (size_t)layer * p.NT * 256; }
__device__ __forceinline__ unsigned f32_to_e4m3(float x) {
    const unsigned u = f2u(x), sign = (u >> 24) & 0x80u; unsigned a = u & 0x7fffffffu;
    if (a >= 0x43E00000u) return sign | 0x7Eu;
    if (a < 0x3C800000u) { const int m = (int)rintf(u2f(a) * 512.f); return sign | (unsigned)m; }
    a += 0x0007FFFFu + ((a >> 20) & 1u);
    return sign | ((((a >> 23) - 120u) << 3) | ((a >> 20) & 7u));
}
__device__ __forceinline__ float e4m3_to_f32_sw(unsigned b) { return u2f(((b & 0x80u) << 24) | ((b & 0x7Fu) << 20)) * 1.329227995784916e36f; }
typedef float f32x2 __attribute__((ext_vector_type(2)));
__device__ __forceinline__ void fp8x4_to_f32(unsigned w, float (&o)[4]) {
#ifdef CPU_EMU
    o[0] = e4m3_to_f32_sw(w & 255u); o[1] = e4m3_to_f32_sw((w >> 8) & 255u); o[2] = e4m3_to_f32_sw((w >> 16) & 255u); o[3] = e4m3_to_f32_sw(w >> 24);
#else
    const f32x2 lo = __builtin_amdgcn_cvt_pk_f32_fp8((int)w, false), hi = __builtin_amdgcn_cvt_pk_f32_fp8((int)w, true);
    o[0] = lo[0]; o[1] = lo[1]; o[2] = hi[0]; o[3] = hi[1];
#endif
}
__device__ __forceinline__ void fp8x4_to_f32x2(unsigned w, f32x2& lo, f32x2& hi) {
#ifdef CPU_EMU
    lo[0] = e4m3_to_f32_sw(w & 255u); lo[1] = e4m3_to_f32_sw((w >> 8) & 255u); hi[0] = e4m3_to_f32_sw((w >> 16) & 255u); hi[1] = e4m3_to_f32_sw(w >> 24);
#else
    lo = __builtin_amdgcn_cvt_pk_f32_fp8((int)w, false); hi = __builtin_amdgcn_cvt_pk_f32_fp8((int)w, true);
#endif
}
constexpr int S5PT_ITEMS = 2 * 2 * 16 * 64 * 128 / 256, S5BC_ITEMS = 2 * 2 * 16 * 64 * 16 / 256 + 2 * 2 * 16 * 16 * 128 / 256;
__device__ __forceinline__ void s5_tables(const Params& p, int vb) {
    const int id = vb * 256 + TIDX;
    if (vb < S5PT_ITEMS) {
        const int tau = id & 127, pp = (id >> 7) & 63, combo = id >> 13, dir = (combo >> 4) & 1, idx = combo * 64 + pp;
        const float are = p.s5_a_re[idx], aim = p.s5_a_im[idx], dt = expf(p.s5_log_dt[idx]), k = (float)(dir ? tau : 127 - tau);
        const float mg = expf(are * dt * k), re = mg * cosf(aim * dt * k), im = mg * sinf(aim * dt * k);
        p.s5_pt[((size_t)combo * 128 + pp) * 128 + tau] = f2bf(re); p.s5_pt[((size_t)combo * 128 + 64 + pp) * 128 + tau] = f2bf(im);
    } else if (vb >= S5PT_ITEMS + 2 * 2 * 16 * 64 * 16 / 256) {
        const int id3 = id - (S5PT_ITEMS + 2 * 2 * 16 * 64 * 16 / 256) * 256, k = id3 & 127, cc = id3 >> 7;
        p.s5_cm[id3] = f2bf(k < 64 ? p.s5_c_re[cc * 64 + k] : -p.s5_c_im[cc * 64 + k - 64]);
    } else {
        const int id2 = id - S5PT_ITEMS * 256, h = id2 & 15, pp = (id2 >> 4) & 63, combo = id2 >> 10, idx = combo * 64 + pp;
        const float are = p.s5_a_re[idx], aim = p.s5_a_im[idx], dt = expf(p.s5_log_dt[idx]);
        const float mg = expf(are * dt), abr = mg * cosf(aim * dt), abi = mg * sinf(aim * dt);
        const float den = 1.f / (are * are + aim * aim), nr = abr - 1.f, ni = abi;
        const float cr = (nr * are + ni * aim) * den, ci = (ni * are - nr * aim) * den;
        const float br = p.s5_b_re[idx * 16 + h], bi = p.s5_b_im[idx * 16 + h];
        p.s5_bc[((size_t)idx * 16 + h) * 2] = cr * br - ci * bi; p.s5_bc[((size_t)idx * 16 + h) * 2 + 1] = cr * bi + ci * br;
        { const int combo2 = idx >> 6;
          p.s5_bcb[((size_t)combo2 * 128 + pp) * 16 + h] = f2bf(cr * br - ci * bi); p.s5_bcb[((size_t)combo2 * 128 + 64 + pp) * 16 + h] = f2bf(cr * bi + ci * br); }
        if (h == 0) { const float m128 = expf(are * dt * 128.f);
            p.s5_ab[idx * 4] = abr; p.s5_ab[idx * 4 + 1] = abi; p.s5_ab[idx * 4 + 2] = m128 * cosf(aim * dt * 128.f); p.s5_ab[idx * 4 + 3] = m128 * sinf(aim * dt * 128.f); }
    }
}
__device__ __forceinline__ void transpose_tile(const float* W, bf16_t* Wt, int K, int N, int tile, unsigned char* smem) {
    float* T = (float*)smem;
    const int tn = N / 64, tk0 = (tile / tn) * 64, tn0 = (tile % tn) * 64, tid = TIDX;
    __syncthreads();
    for (int i = 0; i < 16; ++i) { int idx = tid + i * 256, kk = idx >> 6, nn = idx & 63; T[kk * 65 + nn] = W[(size_t)(tk0 + kk) * N + tn0 + nn]; }
    __syncthreads();
    for (int i = 0; i < 16; ++i) { int idx = tid + i * 256, nn = idx >> 6, kk = idx & 63; Wt[(size_t)(tn0 + nn) * K + tk0 + kk] = f2bf(T[kk * 65 + nn]); }
}
constexpr int T_IN = (D / 64) * (PROJ / 64), T_OUT = (D / 64) * (D / 64), T_PQ = T_OUT, T_GLU = 16;
constexpr int T_PER_LAYER = T_IN + T_OUT + T_PQ + T_GLU;
constexpr int MOD_ITEMS = 2 * (NMOD * D / 64);
constexpr int KEY_ITEMS = 2 * 2 * 8 * 128 * 64 / 2048;
constexpr int TAB_ROWS = 2;
constexpr int TAB_ITEMS = 2 * 2 * NEXP / (4 * TAB_ROWS);
__device__ __forceinline__ void phase_prologue(const Params& p, int vb, unsigned char* smem) {
    const int tid = TIDX;
    if (vb < MOD_ITEMS) vb += 2 * T_PER_LAYER; else if (vb < MOD_ITEMS + 2 * T_PER_LAYER) vb -= MOD_ITEMS;
    if (vb < 2 * T_PER_LAYER) {
        int l = vb / T_PER_LAYER, t = vb % T_PER_LAYER;
        if (t < T_IN) transpose_tile(p.w_in + (size_t)l * D * PROJ, p.wt_in + (size_t)l * D * PROJ, D, PROJ, t, smem);
        else if ((t -= T_IN) < T_OUT) transpose_tile(p.w_out + (size_t)l * D * D, p.wt_out + (size_t)l * D * D, D, D, t, smem);
        else if ((t -= T_OUT) < T_PQ) transpose_tile(p.peer_wq + (size_t)l * D * D, p.wt_pq + (size_t)l * D * D, D, D, t, smem);
        else { t -= T_PQ; transpose_tile(p.s5_glu_w + (size_t)l * 256 * 256, p.wt_glu + (size_t)l * 256 * 256, 256, 256, t, smem); }
        return;
    }
    vb -= 2 * T_PER_LAYER;
    if (vb < MOD_ITEMS) {
        const int l = vb / (NMOD * D / 64), col0 = (vb % (NMOD * D / 64)) * 64, nrow = p.B + 1;
        float* sc = (float*)smem;
        float* red = sc + 9 * 1024;
        __syncthreads();
        for (int i = tid; i < nrow * 1024; i += 256) { int r = i >> 10, k = i & 1023; float v = r < p.B ? p.c[r * 1024 + k] : p.c_ctx[k]; sc[i] = siluf_(v); }
        __syncthreads();
        const int cl = tid & 63, ks = tid >> 6;
        float acc[9]; for (int r = 0; r < 9; ++r) acc[r] = 0.f;
        const GLOBAL_AS float* w = (const GLOBAL_AS float*)(p.ada_w + (size_t)l * D * (NMOD * D) + col0 + cl);
#pragma unroll 1
        for (int k0 = ks * 256; k0 < ks * 256 + 256; k0 += 16) { float wv[16];
#pragma unroll
            for (int kk = 0; kk < 16; ++kk) wv[kk] = w[(size_t)(k0 + kk) * (NMOD * D)];
#pragma unroll
            for (int kk = 0; kk < 16; ++kk)
#pragma unroll
                for (int r = 0; r < 9; ++r) acc[r] += sc[r * 1024 + k0 + kk] * wv[kk]; }
#pragma unroll
        for (int r = 0; r < 9; ++r) red[(ks * 9 + r) * 64 + cl] = acc[r];
        __syncthreads();
        for (int i = tid; i < nrow * 64; i += 256) { int r = i >> 6, c2 = i & 63; float s = p.ada_b[l * NMOD * D + col0 + c2];
            for (int q = 0; q < 4; ++q) s += red[(q * 9 + r) * 64 + c2];
            p.mod[(size_t)(l * nrow + r) * NMOD * D + col0 + c2] = s; }
        return;
    }
    vb -= MOD_ITEMS;
    if (vb < KEY_ITEMS) { for (int i = tid; i < 2048; i += 256) p.kb16[(size_t)vb * 2048 + i] = f2bf(p.peer_keys[(size_t)vb * 2048 + i]); return; }
    vb -= KEY_ITEMS;
    if (vb < S5PT_ITEMS + S5BC_ITEMS) { s5_tables(p, vb); return; }
    vb -= S5PT_ITEMS + S5BC_ITEMS;
    if (vb < TAB_ITEMS) {
        const int lane = tid & 63, row0 = (vb * 4 + (tid >> 6)) * TAB_ROWS;
        f32x4 x[TAB_ROWS][4];
#pragma unroll
        for (int q = 0; q < TAB_ROWS; ++q) { const int row = row0 + q, tab = row / (2 * NEXP), rr = row % (2 * NEXP);
            const GLOBAL_AS float* src = (const GLOBAL_AS float*)((tab ? p.peer_v : p.peer_u) + (size_t)rr * D + lane * 16);
#pragma unroll
            for (int i = 0; i < 4; ++i) x[q][i] = *(const GLOBAL_AS f32x4*)(src + i * 4); }
#pragma unroll
        for (int q = 0; q < TAB_ROWS; ++q) { const int row = row0 + q, tab = row / (2 * NEXP), rr = row % (2 * NEXP);
            float amax = 0.f;
#pragma unroll
            for (int i = 0; i < 4; ++i)
#pragma unroll
                for (int j = 0; j < 4; ++j) amax = fmaxf(amax, fabsf(x[q][i][j]));
            for (int m = 32; m >= 1; m >>= 1) amax = fmaxf(amax, __shfl_xor(amax, m));
            const float scale = amax > 0.f ? amax * (1.f / 448.f) : 1.f, inv = 1.f / scale;
            unsigned wq[4];
#pragma unroll
            for (int i = 0; i < 4; ++i) {
#ifdef CPU_EMU
                wq[i] = f32_to_e4m3(x[q][i][0] * inv) | (f32_to_e4m3(x[q][i][1] * inv) << 8) | (f32_to_e4m3(x[q][i][2] * inv) << 16) | (f32_to_e4m3(x[q][i][3] * inv) << 24);
#else
                int pk = __builtin_amdgcn_cvt_pk_fp8_f32(x[q][i][0] * inv, x[q][i][1] * inv, 0, false);
                pk = __builtin_amdgcn_cvt_pk_fp8_f32(x[q][i][2] * inv, x[q][i][3] * inv, pk, true); wq[i] = (unsigned)pk;
#endif
            }
            typedef unsigned u32x4 __attribute__((ext_vector_type(4)));
            unsigned char* dst = tab ? p.vfp8 + ((size_t)((rr / NEXP) * 8 + (lane >> 3)) * NEXP + (rr % NEXP)) * 128 + (lane & 7) * 16
                                     : p.ufp8 + (size_t)rr * D + lane * 16;
            *(u32x4*)dst = (u32x4){wq[0], wq[1], wq[2], wq[3]};
            if (lane == 0) (tab ? p.vscale : p.uscale)[rr] = scale; }
        return;
    }
    vb -= TAB_ITEMS;
    {
        int t = vb * 8 + (tid >> 5), i = tid & 31;
        if (t < p.SEQ) {
            float row = (float)(t / 64), col = (float)(t % 64);
            float inv = powf(10000.0f, -(float)(i & 15) / 16.0f);
            float ang = (i < 16 ? row : col) * inv;
            p.ropeA[(t * 32 + i) * 2] = cosf(ang); p.ropeA[(t * 32 + i) * 2 + 1] = sinf(ang);
            float inv2 = powf(10000.0f, -(float)i / 32.0f); float ang2 = (float)t * inv2;
            p.ropeR[(t * 32 + i) * 2] = cosf(ang2); p.ropeR[(t * 32 + i) * 2 + 1] = sinf(ang2);
        }
    }
}
__device__ __forceinline__ int prologue_items(const Params& p) { return 2 * T_PER_LAYER + MOD_ITEMS + KEY_ITEMS + S5PT_ITEMS + S5BC_ITEMS + TAB_ITEMS + (p.SEQ + 7) / 8; }

template <int WHICH  >
__device__ __forceinline__ void phase_norm(const Params& p, int layer, int vb, int nrows) {
    constexpr int NR = 2;
    const int lane = TIDX & 63, r0 = vb * (4 * NR) + (TIDX >> 6) * NR;
    if (r0 >= nrows) return;
    const float* nw = (WHICH == 0 ? p.norm1_w : p.norm2_w) + layer * D;
    f32x4 v[NR][4]; bf16x4 pv[NR][4]; f32x4 g2[NR][4];
#pragma unroll
    for (int q = 0; q < NR; ++q) { const int r = r0 + q; const float* src = (WHICH == 0) ? xsrc_row(p, layer, r) : xdst_row(p, r); const int mr = mod_row(p, r);
#pragma unroll
        for (int i = 0; i < 4; ++i) { const int c0 = i * 256 + lane * 4; v[q][i] = *(const f32x4*)(src + c0);
            if (WHICH == 0 && layer > 0) { pv[q][i] = *(const bf16x4*)(L_po(p, layer - 1) + (size_t)r * D + c0); g2[q][i] = *(const f32x4*)(mod_ptr(p, layer - 1, mr, 5) + c0); } } }
#pragma unroll
    for (int q = 0; q < NR; ++q) { const int r = r0 + q; const int mr = mod_row(p, r);
        const float* sh = mod_ptr(p, layer, mr, WHICH ? 3 : 0); const float* sc = mod_ptr(p, layer, mr, WHICH ? 4 : 1);
        float ss = 0.f;
#pragma unroll
        for (int i = 0; i < 4; ++i) {
            if (WHICH == 0 && layer > 0) {
                const int c0 = i * 256 + lane * 4;
#pragma unroll
                for (int j = 0; j < 4; ++j) v[q][i][j] += g2[q][i][j] * bf2f((bf16_t)pv[q][i][j]);
                *(f32x4*)(xdst_row(p, r) + c0) = v[q][i]; }
            ss += v[q][i][0] * v[q][i][0] + v[q][i][1] * v[q][i][1] + v[q][i][2] * v[q][i][2] + v[q][i][3] * v[q][i][3]; }
        f32x4 nw4[4], sc4[4], sh4[4];
#pragma unroll
        for (int i = 0; i < 4; ++i) { const int c0 = i * 256 + lane * 4; nw4[i] = *(const f32x4*)(nw + c0); sc4[i] = *(const f32x4*)(sc + c0); sh4[i] = *(const f32x4*)(sh + c0); }
        ss = wave_sum(ss);
        const float rstd = rsqrtf(ss * (1.0f / D) + EPS);
#pragma unroll
        for (int i = 0; i < 4; ++i) { const int c0 = i * 256 + lane * 4; bf16x4 o;
#pragma unroll
            for (int j = 0; j < 4; ++j) { float y = v[q][i][j] * rstd * nw4[i][j]; y = y * (1.f + sc4[i][j]) + sh4[i][j]; o[j] = (short)f2bf(y); }
            *(bf16x4*)(p.hb + (size_t)r * D + c0) = o; } }
}

constexpr int GLD = 72;
template <class Epi>
__device__ __forceinline__ void gemm_tile(const bf16_t* A, int lda, const bf16_t* Bt, int ldb, int K, int m0, int n0, unsigned char* smem, const Epi& epi) {
    bf16_t* S0 = (bf16_t*)smem;
    const int tid = TIDX, lane = tid & 63, wid = tid >> 6, wr = wid >> 1, wc = wid & 1, fr = lane & 15, fq = lane >> 4;
    f32x4 acc[4][4];
#pragma unroll
    for (int i = 0; i < 4; ++i)
#pragma unroll
        for (int j = 0; j < 4; ++j) acc[i][j] = (f32x4){0.f, 0.f, 0.f, 0.f};
    bf16x8 pa[2][4], pb[2][4];
    auto gload = [&](bf16x8 (&qa)[4], bf16x8 (&qb)[4], int k0) {
#pragma unroll
        for (int i = 0; i < 4; ++i) { const int ch = tid + i * 256, row = ch >> 3, cc = ch & 7;
            qa[i] = *(const bf16x8*)(A + (size_t)(m0 + row) * lda + k0 + cc * 8); qb[i] = *(const bf16x8*)(Bt + (size_t)(n0 + row) * ldb + k0 + cc * 8); } };
    auto stage = [&](const bf16x8 (&qa)[4], const bf16x8 (&qb)[4], int st) { bf16_t* As = S0 + st * 16384; bf16_t* Bs = As + 8192;
#pragma unroll
        for (int i = 0; i < 4; ++i) { const int ch = tid + i * 256, row = ch >> 3, cc = (ch & 7) ^ (row & 7);
            *(bf16x8*)(As + row * 64 + cc * 8) = qa[i]; *(bf16x8*)(Bs + row * 64 + cc * 8) = qb[i]; } };
    auto mma = [&](int st) { const bf16_t* As = S0 + st * 16384; const bf16_t* Bs = As + 8192;
#pragma unroll
        for (int kk = 0; kk < 2; ++kk) {
            bf16x8 a[4], b[4];
#pragma unroll
            for (int i = 0; i < 4; ++i) { const int ra = wr * 64 + i * 16 + fr, rb = wc * 64 + i * 16 + fr;
                a[i] = *(const bf16x8*)(As + ra * 64 + (((kk * 4 + fq) ^ (ra & 7)) * 8)); b[i] = *(const bf16x8*)(Bs + rb * 64 + (((kk * 4 + fq) ^ (rb & 7)) * 8)); }
#pragma unroll
            for (int i = 0; i < 4; ++i)
#pragma unroll
                for (int j = 0; j < 4; ++j) acc[i][j] = __builtin_amdgcn_mfma_f32_16x16x32_bf16(a[i], b[j], acc[i][j], 0, 0, 0);
        } };
    gload(pa[0], pb[0], 0); gload(pa[1], pb[1], 64);
    __syncthreads();
    stage(pa[0], pb[0], 0); gload(pa[0], pb[0], 128);
    __syncthreads();
    for (int k0 = 0; k0 < K; k0 += 128) {
        stage(pa[1], pb[1], 1); if (k0 + 192 < K) gload(pa[1], pb[1], k0 + 192); mma(0); __syncthreads();
        if (k0 + 128 < K) { stage(pa[0], pb[0], 0); if (k0 + 256 < K) gload(pa[0], pb[0], k0 + 256); } mma(1); __syncthreads();
    }
    if constexpr (Epi::TILE) { epi.tile(acc, m0 + wr * 64, n0 + wc * 64, fr, fq, (bf16_t*)smem + wid * (64 * GLD), lane); }
    else {
#pragma unroll
    for (int i = 0; i < 4; ++i)
#pragma unroll
        for (int j = 0; j < 4; ++j)
#pragma unroll
            for (int r = 0; r < 4; ++r) epi(m0 + wr * 64 + i * 16 + fq * 4 + r, n0 + wc * 64 + j * 16 + fr, acc[i][j][r]);
    }
}
struct EpiStoreF32 { static constexpr bool TILE = false; float* C; int ldc; __device__ __forceinline__ void operator()(int r, int c, float v) const { C[(size_t)r * ldc + c] = v; } };
struct EpiStoreBf16 {
    static constexpr bool TILE = true; bf16_t* C; int ldc;
    __device__ __forceinline__ void tile(const f32x4 (&acc)[4][4], int row0, int c0, int fr, int fq, bf16_t* T, int lane) const {
#pragma unroll
        for (int i = 0; i < 4; ++i)
#pragma unroll
            for (int j = 0; j < 4; ++j)
#pragma unroll
                for (int r = 0; r < 4; ++r) T[(i * 16 + fq * 4 + r) * GLD + j * 16 + fr] = f2bf(acc[i][j][r]);
        WAVE_SYNC();
#pragma unroll
        for (int i = 0; i < 8; ++i) { const int idx = lane + i * 64, rr = idx >> 3, ch = idx & 7;
            *(bf16x8*)(C + (size_t)(row0 + rr) * ldc + c0 + ch * 8) = *(const bf16x8*)(T + rr * GLD + ch * 8); }
        WAVE_SYNC();
    } };
struct EpiResidual {
    static constexpr bool TILE = true;
    const float *src_lat, *src_ctx, *gate; float *dst_lat, *dst_ctx; int NTOK, SEQ, B;
    __device__ __forceinline__ void tile(const f32x4 (&acc)[4][4], int row0, int c0, int fr, int fq, bf16_t* T, int lane) const {
        float* Tf = (float*)T; constexpr int FLD = 68;
#pragma unroll
        for (int half = 0; half < 2; ++half) {
#pragma unroll
            for (int ii = 0; ii < 2; ++ii)
#pragma unroll
                for (int j = 0; j < 4; ++j)
#pragma unroll
                    for (int r = 0; r < 4; ++r) Tf[(ii * 16 + fq * 4 + r) * FLD + j * 16 + fr] = acc[half * 2 + ii][j][r];
            WAVE_SYNC();
            f32x4 xs[8], gs[8];
#pragma unroll
            for (int k = 0; k < 8; ++k) { const int idx = lane + k * 64, rr = idx >> 4, c4 = idx & 15, row = row0 + half * 32 + rr, col = c0 + c4 * 4; const bool lat = row < NTOK;
                gs[k] = *(const f32x4*)(gate + (size_t)(lat ? row / SEQ : B) * NMOD * D + col);
                xs[k] = *(const f32x4*)((lat ? src_lat : src_ctx) + (lat ? (size_t)row * D + col : (size_t)(row - NTOK) * D + col)); }
#pragma unroll
            for (int k = 0; k < 8; ++k) { const int idx = lane + k * 64, rr = idx >> 4, c4 = idx & 15, row = row0 + half * 32 + rr, col = c0 + c4 * 4; const bool lat = row < NTOK;
                const f32x4 v = *(const f32x4*)(Tf + rr * FLD + c4 * 4);
                const size_t o = lat ? (size_t)row * D + col : (size_t)(row - NTOK) * D + col;
                *(f32x4*)((lat ? dst_lat : dst_ctx) + o) = xs[k] + gs[k] * v; }
            WAVE_SYNC();
        }
    } };
__device__ __forceinline__ EpiResidual make_epi_residual(const Params& p, int layer) {
    EpiResidual e; e.src_lat = layer == 0 ? p.x : p.out; e.src_ctx = layer == 0 ? p.ctx : p.ctxs; e.dst_lat = p.out; e.dst_ctx = p.ctxs;
    e.gate = p.mod + ((size_t)(layer * (p.B + 1)) * NMOD + 2) * D; e.NTOK = p.NTOK; e.SEQ = p.SEQ; e.B = p.B; return e; }
struct EpiGlu {
    static constexpr bool TILE = true;
    const bf16_t* yg; bf16_t* mix; const float* bias;
    __device__ __forceinline__ void tile(const f32x4 (&acc)[4][4], int row0, int c0, int fr, int fq, bf16_t* T, int lane) const {
        float* Tf = (float*)T; constexpr int FLD = 68;
        float bj[4];
#pragma unroll
        for (int j = 0; j < 4; ++j) bj[j] = bias[c0 + j * 16 + fr];
#pragma unroll
        for (int half = 0; half < 2; ++half) {
#pragma unroll
            for (int ii = 0; ii < 2; ++ii)
#pragma unroll
                for (int j = 0; j < 4; ++j)
#pragma unroll
                    for (int r = 0; r < 4; ++r) Tf[(ii * 16 + fq * 4 + r) * FLD + j * 16 + fr] = sigmoidf_(acc[half * 2 + ii][j][r] + bj[j]);
            WAVE_SYNC();
            bf16x4 ys[8];
#pragma unroll
            for (int k = 0; k < 8; ++k) { const int idx = lane + k * 64, rr = idx >> 4, c4 = idx & 15; ys[k] = *(const bf16x4*)(yg + (size_t)(row0 + half * 32 + rr) * 256 + c0 + c4 * 4); }
#pragma unroll
            for (int k = 0; k < 8; ++k) { const int idx = lane + k * 64, rr = idx >> 4, c4 = idx & 15, row = row0 + half * 32 + rr, col = c0 + c4 * 4;
                const f32x4 gt = *(const f32x4*)(Tf + rr * FLD + c4 * 4); const bf16x4 y = ys[k]; bf16x4 o;
#pragma unroll
                for (int e = 0; e < 4; ++e) o[e] = (short)f2bf(bf2f((bf16_t)y[e]) * gt[e]);
                *(bf16x4*)(mix + (size_t)row * D + 512 + col) = o; }
            WAVE_SYNC();
        }
    } };

struct EpiIn {
    static constexpr bool TILE = true;
    const Params* pp; int layer;
    __device__ __forceinline__ void tile(const f32x4 (&acc)[4][4], int row0, int c0, int fr, int fq, bf16_t* T, int lane) const {
        const Params& p = *pp;
        const int unit = UNIFORM(c0 >> 6);
        const bool isq = unit < 8, isk = unit >= 8 && unit < 10, isv = unit >= 10 && unit < 12, isrq = unit >= 16 && unit < 20, isrk = unit >= 20 && unit < 24;
        const float* nw = (isq ? p.q_norm_w : p.k_norm_w) + layer * 64;
        bf16_t* akv = L_akv(p, layer);
        if (isv) {
#pragma unroll
            for (int i = 0; i < 4; ++i)
#pragma unroll
                for (int j = 0; j < 4; ++j) { bf16x4 o;
#pragma unroll
                    for (int r = 0; r < 4; ++r) o[r] = (short)f2bf(acc[i][j][r]);
                    *(bf16x4*)(T + (j * 16 + fr) * GLD + i * 16 + fq * 4) = o; }
            WAVE_SYNC();
            bf16_t* dst = p.avt + (size_t)layer * p.NT * 128 + (size_t)(row0 >> 7) * 16384 + (size_t)(c0 - ZV) * 128 + (row0 & 127);
#pragma unroll
            for (int i = 0; i < 8; ++i) { const int idx = lane + i * 64, rr = idx >> 3, ch = idx & 7;
                *(bf16x8*)(dst + rr * 128 + ch * 8) = *(const bf16x8*)(T + rr * GLD + ch * 8); }
            WAVE_SYNC();
            return;
        }
        const bool norm = isq || isk, rope = (isq || isk || isrq || isrk) && (UNIFORM(row0) < p.NTOK);
        const float* tab = (isq || isk) ? p.ropeA : p.ropeR;
        float nwv[4] = {1.f, 1.f, 1.f, 1.f};
        if (norm) {
#pragma unroll
            for (int j = 0; j < 4; ++j) nwv[j] = nw[j * 16 + fr]; }
        const float sc = isq ? 0.125f * 1.44269504f : (isrq ? 0.125f : 1.f);
#pragma unroll
        for (int ih = 0; ih < 2; ++ih) {
            f32x2 cs[8][2];
            if (rope) {
#pragma unroll
                for (int q = 0; q < 8; ++q) { const int t = (row0 + (ih * 2 + (q >> 2)) * 16 + fq * 4 + (q & 3)) % p.SEQ;
#pragma unroll
                    for (int j = 0; j < 2; ++j) cs[q][j] = *(const f32x2*)(tab + (t * 32 + j * 16 + fr) * 2); } }
#pragma unroll
            for (int q = 0; q < 8; ++q) { const int i = ih * 2 + (q >> 2), r = q & 3;
                float x[4] = {acc[i][0][r], acc[i][1][r], acc[i][2][r], acc[i][3][r]};
                if (norm) {
                    float ss = x[0] * x[0] + x[1] * x[1] + x[2] * x[2] + x[3] * x[3];
                    ss = red16_sum(ss);
                    const float rstd = rsqrtf(ss * (1.f / 64.f) + EPS);
#pragma unroll
                    for (int j = 0; j < 4; ++j) x[j] *= rstd * nwv[j];
                }
                if (rope) {
#pragma unroll
                    for (int j = 0; j < 2; ++j) { const float c = cs[q][j][0], sn = cs[q][j][1];
                        const float o1 = x[j] * c - x[j + 2] * sn, o2 = x[j] * sn + x[j + 2] * c; x[j] = o1; x[j + 2] = o2; }
                }
#pragma unroll
                for (int j = 0; j < 4; ++j) T[(i * 16 + fq * 4 + r) * GLD + j * 16 + fr] = f2bf(x[j] * sc);
            }
        }
        WAVE_SYNC();
        bf16_t* dst; int ld;
        if (isk) { dst = akv + (c0 - ZK); ld = 256; } else { dst = p.zb + c0; ld = PROJ; }
#pragma unroll
        for (int i = 0; i < 8; ++i) { const int idx = lane + i * 64, rr = idx >> 3, ch = idx & 7;
            *(bf16x8*)(dst + (size_t)(row0 + rr) * ld + ch * 8) = *(const bf16x8*)(T + rr * GLD + ch * 8); }
        WAVE_SYNC();
    }
};

constexpr int KLD = 72, VLD = 136;
__device__ __forceinline__ void attn_item(const Params& p, int layer, int qrow0, int b, int qb  , int h, unsigned char* smem) {
    bf16_t* Ks = (bf16_t*)smem; bf16_t* Vt = Ks + 128 * KLD;
    const int tid = TIDX, lane = tid & 63, w = tid >> 6, fr = lane & 15, fq = lane >> 4, hkv = h >> 2;
    bf16x8 qf[2][2];
#pragma unroll
    for (int nt = 0; nt < 2; ++nt)
#pragma unroll
        for (int ks = 0; ks < 2; ++ks) qf[nt][ks] = *(const bf16x8*)(p.zb + (size_t)(qrow0 + w * 32 + nt * 16 + fr) * PROJ + ZQ + h * 64 + ks * 32 + fq * 8);
    const float sink = p.attn_sink[layer * 8 + h] * 1.44269504f;
    float m_[2] = {sink, sink}, l_[2] = {0.f, 0.f};
    f32x4 o[4][2];
#pragma unroll
    for (int i = 0; i < 4; ++i) { o[i][0] = (f32x4){0.f, 0.f, 0.f, 0.f}; o[i][1] = o[i][0]; }
    const int kb0 = qb < 0 ? 0 : (qb > 0 ? qb - 1 : 0), kb1 = qb < 0 ? -1 : (qb + 1 < p.NLC ? qb + 1 : p.NLC - 1);
    const int ntile = p.NCC + (kb1 - kb0 + 1);
    const bf16_t* Kg = L_akv(p, layer) + hkv * 64; const bf16_t* Vg = p.avt + (size_t)layer * p.NT * 128 + hkv * 64 * 128;
    auto tile_row0 = [&](int ti) { return ti < p.NCC ? p.NTOK + b * p.CTX + ti * 128 : b * p.SEQ + (kb0 + (ti - p.NCC)) * 128; };
    bf16x8 kreg[4], vreg[4];
    auto tile_load = [&](int ti) { const int kr = tile_row0(ti);
#pragma unroll
        for (int i = 0; i < 4; ++i) { const int idx = tid + i * 256;
            kreg[i] = *(const bf16x8*)(Kg + (size_t)(kr + (idx >> 3)) * 256 + (idx & 7) * 8);
            vreg[i] = *(const bf16x8*)(Vg + (size_t)(kr >> 7) * 16384 + idx * 8); } };
    tile_load(0);
    for (int ti = 0; ti < ntile; ++ti) {
        int mask = 0;
        if (ti >= p.NCC) { const int kb = kb0 + (ti - p.NCC); mask = (kb < qb) ? 1 : (kb > qb ? 2 : 0); }
        mask = UNIFORM(mask);
        __syncthreads();
#pragma unroll
        for (int i = 0; i < 4; ++i) { const int idx = tid + i * 256;
            *(bf16x8*)(Ks + (idx >> 3) * KLD + (idx & 7) * 8) = kreg[i];
            *(bf16x8*)(Vt + (idx >> 4) * VLD + (idx & 15) * 8) = vreg[i]; }
        __syncthreads();
        if (ti + 1 < ntile) tile_load(ti + 1);
#pragma unroll 1
        for (int kh = 0; kh < 2; ++kh) {
        f32x4 s[4][2];
#pragma unroll
        for (int mt = 0; mt < 4; ++mt) { s[mt][0] = (f32x4){0.f, 0.f, 0.f, 0.f}; s[mt][1] = s[mt][0];
#pragma unroll
            for (int ks = 0; ks < 2; ++ks) { bf16x8 a = *(const bf16x8*)(Ks + (kh * 64 + mt * 16 + fr) * KLD + ks * 32 + fq * 8);
                s[mt][0] = __builtin_amdgcn_mfma_f32_16x16x32_bf16(a, qf[0][ks], s[mt][0], 0, 0, 0);
                s[mt][1] = __builtin_amdgcn_mfma_f32_16x16x32_bf16(a, qf[1][ks], s[mt][1], 0, 0, 0); } }
#pragma unroll
        for (int nt = 0; nt < 2; ++nt) {
            const int qq = w * 32 + nt * 16 + fr; float mx = -3.0e38f;
            const int klo = mask == 1 ? qq : -(1 << 30), khi = mask == 2 ? qq : (1 << 30);
            if (mask != 0) {
#pragma unroll
                for (int mt = 0; mt < 4; ++mt)
#pragma unroll
                    for (int r = 0; r < 4; ++r) { const int kk = kh * 64 + mt * 16 + fq * 4 + r; const float v = (kk >= klo && kk <= khi) ? s[mt][nt][r] : -3.0e38f; s[mt][nt][r] = v; mx = fmaxf(mx, v); }
            } else {
#pragma unroll
                for (int mt = 0; mt < 4; ++mt)
#pragma unroll
                    for (int r = 0; r < 4; ++r) mx = fmaxf(mx, s[mt][nt][r]);
            }
            mx = fmaxf(mx, __shfl_xor(mx, 16)); mx = fmaxf(mx, __shfl_xor(mx, 32));
            const float mn = fmaxf(m_[nt], mx), alpha = EXP2(m_[nt] - mn); m_[nt] = mn; float ls = 0.f;
#pragma unroll
            for (int mt = 0; mt < 4; ++mt)
#pragma unroll
                for (int r = 0; r < 4; ++r) { float e = EXP2(s[mt][nt][r] - mn); s[mt][nt][r] = e; ls += e; }
            l_[nt] = l_[nt] * alpha + ls;
#pragma unroll
            for (int dt = 0; dt < 4; ++dt) o[dt][nt] *= alpha;
        }
#pragma unroll
        for (int ks2 = 0; ks2 < 2; ++ks2) {
            bf16x8 pb[2];
#pragma unroll
            for (int nt = 0; nt < 2; ++nt)
#pragma unroll
                for (int j = 0; j < 8; ++j) pb[nt][j] = (short)f2bf(s[2 * ks2 + (j >> 2)][nt][j & 3]);
#pragma unroll
            for (int dt = 0; dt < 4; ++dt) { const bf16_t* vp = Vt + (dt * 16 + fr) * VLD + kh * 64 + fq * 4;
                bf16x4 v0 = *(const bf16x4*)(vp + (2 * ks2) * 16), v1 = *(const bf16x4*)(vp + (2 * ks2 + 1) * 16);
                bf16x8 a = (bf16x8){v0[0], v0[1], v0[2], v0[3], v1[0], v1[1], v1[2], v1[3]};
                o[dt][0] = __builtin_amdgcn_mfma_f32_16x16x32_bf16(a, pb[0], o[dt][0], 0, 0, 0);
                o[dt][1] = __builtin_amdgcn_mfma_f32_16x16x32_bf16(a, pb[1], o[dt][1], 0, 0, 0); }
        }
        }
    }
#pragma unroll
    for (int nt = 0; nt < 2; ++nt) {
        float l = l_[nt]; l += __shfl_xor(l, 16); l += __shfl_xor(l, 32); l += EXP2(sink - m_[nt]);
        const float inv = 1.f / l; const int row = qrow0 + w * 32 + nt * 16 + fr;
#pragma unroll
        for (int dt = 0; dt < 4; ++dt) { bf16x4 ov;
#pragma unroll
            for (int r = 0; r < 4; ++r) ov[r] = (short)f2bf(o[dt][nt][r] * inv);
            *(bf16x4*)(p.mix + (size_t)row * D + h * 64 + dt * 16 + fq * 4) = ov; }
    }
}

struct cplx { float re, im; };
__device__ __forceinline__ cplx cmul(cplx a, cplx b) { return {a.re * b.re - a.im * b.im, a.re * b.im + a.im * b.re}; }
__device__ __forceinline__ void s5_disc(const Params& p, int layer, int dir, int g, int pp, float pw, cplx& abar, cplx& coef) {
    const int idx = ((layer * 2 + dir) * 16 + g) * 64 + pp;
    const float are = p.s5_a_re[idx], aim = p.s5_a_im[idx], dt = expf(p.s5_log_dt[idx]);
    const float mg = expf(are * dt); abar = {mg * cosf(aim * dt), mg * sinf(aim * dt)};
    const float den = 1.f / (are * are + aim * aim); const float nr = abar.re - 1.f, ni = abar.im;
    coef = {(nr * are + ni * aim) * den, (ni * are - nr * aim) * den};
    if (pw != 1.f) { const float mgp = expf(are * dt * pw); abar = {mgp * cosf(aim * dt * pw), mgp * sinf(aim * dt * pw)}; }
}
__device__ __forceinline__ void s5_stage_u(const Params& p, int gc, int g, int lane, float* U) {
#pragma unroll
    for (int i = 0; i < 4; ++i) { const int row = i * 32 + (lane >> 1), q = lane & 1;
        const bf16x8 u8 = *(const bf16x8*)(p.zb + (size_t)(gc * 128 + row) * PROJ + ZSU + g * 16 + q * 8);
#pragma unroll
        for (int e = 0; e < 8; ++e) U[row * 16 + q * 8 + e] = bf2f((bf16_t)u8[e]); }
    WAVE_SYNC();
}
__device__ __forceinline__ void s5_phaseA(const Params& p, int layer, int vb, unsigned char* smem) {
    constexpr int ULD = 136;
    const int lane = TIDX & 63, w = TIDX >> 6, fr = lane & 15, fq = lane >> 4;
    const int dir = vb & 1, gq = (vb >> 1) & 3, gc = vb >> 3, g = gq * 4 + w, combo = (layer * 2 + dir) * 16 + g;
    bf16_t* UT = (bf16_t*)smem + w * (16 * ULD);
    const bf16_t* PT = p.s5_pt + (size_t)combo * 128 * 128;
    const float* BC = p.s5_bc + (size_t)combo * 64 * 16 * 2;
    bf16x8 u8[4], pt[2][8]; f32x2 bc[16];
#pragma unroll
    for (int i = 0; i < 4; ++i) u8[i] = *(const bf16x8*)(p.zb + (size_t)(gc * 128 + i * 32 + (lane >> 1)) * PROJ + ZSU + g * 16 + (lane & 1) * 8);
#pragma unroll
    for (int ks = 0; ks < 2; ++ks)
#pragma unroll
        for (int mt = 0; mt < 8; ++mt) pt[ks][mt] = *(const bf16x8*)(PT + (size_t)(mt * 16 + fr) * 128 + ks * 32 + fq * 8);
#pragma unroll
    for (int q = 0; q < 16; ++q) bc[q] = *(const f32x2*)(BC + ((size_t)((q >> 2) * 16 + fq * 4 + (q & 3)) * 16 + fr) * 2);
    __syncthreads();
#pragma unroll
    for (int i = 0; i < 4; ++i) { const int row = i * 32 + (lane >> 1), q = lane & 1;
#pragma unroll
        for (int e = 0; e < 8; ++e) UT[(q * 8 + e) * ULD + row] = (bf16_t)u8[i][e]; }
    WAVE_SYNC();
    f32x4 acc[8];
#pragma unroll
    for (int mt = 0; mt < 8; ++mt) acc[mt] = (f32x4){0.f, 0.f, 0.f, 0.f};
#pragma unroll
    for (int ks = 0; ks < 4; ++ks) { const bf16x8 b = *(const bf16x8*)(UT + fr * ULD + ks * 32 + fq * 8);
#pragma unroll
        for (int mt = 0; mt < 8; ++mt) { const bf16x8 a = ks < 2 ? pt[ks & 1][mt] : *(const bf16x8*)(PT + (size_t)(mt * 16 + fr) * 128 + ks * 32 + fq * 8); acc[mt] = __builtin_amdgcn_mfma_f32_16x16x32_bf16(a, b, acc[mt], 0, 0, 0); } }
    float* dst = L_hend(p, layer) + ((((size_t)gc * 2 + dir) * 16 + g) * 64) * 2;
#pragma unroll
    for (int mt = 0; mt < 4; ++mt)
#pragma unroll
        for (int r = 0; r < 4; ++r) { const int pp = mt * 16 + fq * 4 + r; const f32x2 bq = bc[mt * 4 + r];
            const float wre = acc[mt][r], wim = acc[mt + 4][r];
            float hr = bq[0] * wre - bq[1] * wim, hi = bq[0] * wim + bq[1] * wre;
            hr = red16_sum(hr); hi = red16_sum(hi);
            if (fr == 0) { dst[pp * 2] = hr; dst[pp * 2 + 1] = hi; } }
}
__device__ __forceinline__ void s5_phaseB(const Params& p, int layer, int vb) {
    const int idx = vb * 256 + TIDX; if (idx >= p.B * 2 * 16 * 64) return;
    const int pp = idx & 63, g = (idx >> 6) & 15, dir = (idx >> 10) & 1, b = idx >> 11;
    const float* abp = p.s5_ab + ((size_t)((layer * 2 + dir) * 16 + g) * 64 + pp) * 4; const cplx a128 = {abp[2], abp[3]};
    float zero = 0.f; OPAQUE_V(zero);
    cplx H = {zero, zero};
    const int npos = p.NCC + p.NLC; constexpr int MAXPOS = 18;
    if (npos <= MAXPOS) {
        f32x2 he[MAXPOS];
#pragma unroll
        for (int pos = 0; pos < MAXPOS; ++pos) if (pos < npos) { const int gc = order_chunk(p, b, dir, pos); he[pos] = *(const f32x2*)(L_hend(p, layer) + ((((size_t)gc * 2 + dir) * 16 + g) * 64 + pp) * 2); }
#pragma unroll
        for (int pos = 0; pos < MAXPOS; ++pos) if (pos < npos) { const int gc = order_chunk(p, b, dir, pos); const size_t o = ((((size_t)gc * 2 + dir) * 16 + g) * 64 + pp) * 2;
            *(f32x2*)(L_hin(p, layer) + o) = (f32x2){H.re, H.im};
            cplx nh = cmul(a128, H); H = {nh.re + he[pos][0], nh.im + he[pos][1]}; }
    } else
    for (int pos = 0; pos < npos; ++pos) {
        const int gc = order_chunk(p, b, dir, pos); const size_t o = ((((size_t)gc * 2 + dir) * 16 + g) * 64 + pp) * 2;
        L_hin(p, layer)[o] = H.re; L_hin(p, layer)[o + 1] = H.im;
        cplx nh = cmul(a128, H); H = {nh.re + L_hend(p, layer)[o], nh.im + L_hend(p, layer)[o + 1]};
    }
}
constexpr int S5_WAVE_LDS = 4096 + 4352 + 8192, S5_HLD = 136;
__device__ __forceinline__ void s5_phaseC(const Params& p, int layer, int vb, unsigned char* smem) {
    static_assert(S5_WAVE_LDS == 4096 + 4352 + 8192, "s5C LDS layout");
    typedef short bf16x4s __attribute__((ext_vector_type(4)));
    const int lane = TIDX & 63, w = TIDX >> 6, gq = vb & 3, gc = vb >> 2, g = gq * 4 + w, fr = lane & 15, fq = lane >> 4;
    bf16_t* UB = (bf16_t*)(smem + w * S5_WAVE_LDS); bf16_t* H = UB + 2048; float* BU = (float*)(H + 16 * S5_HLD);
    bf16x8 u8[4];
#pragma unroll
    for (int i = 0; i < 4; ++i) u8[i] = *(const bf16x8*)(p.zb + (size_t)(gc * 128 + i * 32 + (lane >> 1)) * PROJ + ZSU + g * 16 + (lane & 1) * 8);
    __syncthreads();
#pragma unroll
    for (int i = 0; i < 4; ++i) *(bf16x8*)(UB + (i * 32 + (lane >> 1)) * 16 + (lane & 1) * 8) = u8[i];
    WAVE_SYNC();
#pragma unroll 1
    for (int dir = 0; dir < 2; ++dir) {
        const int combo = (layer * 2 + dir) * 16 + g;
        const f32x2 abv = *(const f32x2*)(p.s5_ab + ((size_t)combo * 64 + lane) * 4);
        const f32x2 hv = *(const f32x2*)(L_hin(p, layer) + ((((size_t)gc * 2 + dir) * 16 + g) * 64 + lane) * 2);
        bf16x4s bcb[8];
#pragma unroll
        for (int t8 = 0; t8 < 8; ++t8) bcb[t8] = *(const bf16x4s*)(p.s5_bcb + ((size_t)combo * 128 + t8 * 16 + fr) * 16 + fq * 4);
        bf16x8 cmf[4];
#pragma unroll
        for (int ks = 0; ks < 4; ++ks) cmf[ks] = *(const bf16x8*)(p.s5_cm + ((size_t)combo * 16 + fr) * 128 + ks * 32 + fq * 8);
        const f32x2 ar2 = {abv[0], abv[0]}, ai2 = {-abv[1], abv[1]}; f32x2 hs = hv;
        const float dcoef = p.s5_d[layer * 256 + g * 16 + fr];
        float yall[8][4];
        if (dir == 1) {
#pragma unroll
            for (int sb = 0; sb < 8; ++sb)
#pragma unroll
                for (int r = 0; r < 4; ++r) yall[sb][r] = p.ytmp[(size_t)gc * 65536 + ((size_t)g * 128 + sb * 16 + fq * 4 + r) * 16 + fr]; }
#pragma unroll 1
        for (int s = 0; s < 8; ++s) {
            const int sub = dir ? 7 - s : s;
            { const bf16x4s ua = *(const bf16x4s*)(UB + (sub * 16 + fr) * 16 + fq * 4);
#pragma unroll
              for (int t8 = 0; t8 < 8; ++t8) { const f32x4 bu = __builtin_amdgcn_mfma_f32_16x16x16bf16_1k(ua, bcb[t8], (f32x4){0.f, 0.f, 0.f, 0.f}, 0, 0, 0);
#pragma unroll
                  for (int r = 0; r < 4; ++r) BU[((fq * 4 + r) * 64 + (t8 & 3) * 16 + fr) * 2 + (t8 >> 2)] = bu[r]; } }
            WAVE_SYNC();
#pragma unroll 4
            for (int t = 0; t < 16; ++t) { const int tl = dir ? 15 - t : t;
                const f32x2 bsum = *(const f32x2*)(BU + (tl * 64 + lane) * 2);
                const f32x2 hsw = __builtin_shufflevector(hs, hs, 1, 0);
                hs = ar2 * hs + (ai2 * hsw + bsum);
                H[tl * S5_HLD + lane] = f2bf(hs[0]); H[tl * S5_HLD + 64 + lane] = f2bf(hs[1]); }
            WAVE_SYNC();
            f32x4 acc = (f32x4){0.f, 0.f, 0.f, 0.f};
#pragma unroll
            for (int ks = 0; ks < 4; ++ks) { const bf16x8 af = *(const bf16x8*)(H + fr * S5_HLD + ks * 32 + fq * 8); acc = __builtin_amdgcn_mfma_f32_16x16x32_bf16(af, cmf[ks], acc, 0, 0, 0); }
            float* yt0 = p.ytmp + (size_t)gc * 65536 + ((size_t)g * 128 + sub * 16 + fq * 4) * 16 + fr;
            if (dir == 0) {
#pragma unroll
                for (int r = 0; r < 4; ++r) yt0[r * 16] = acc[r];
            } else { float yprev[4];
#pragma unroll
                for (int r = 0; r < 4; ++r) { float t = yall[0][r];
#pragma unroll
                    for (int sb = 1; sb < 8; ++sb) t = (sub == sb) ? yall[sb][r] : t;
                    yprev[r] = t; }
#pragma unroll
                for (int r = 0; r < 4; ++r) { const int tk = sub * 16 + fq * 4 + r, row = gc * 128 + tk;
                    p.yg[(size_t)row * 256 + g * 16 + fr] = f2bf(gelu_tanh(yprev[r] + acc[r] + dcoef * bf2f(UB[tk * 16 + fr]))); } }
            WAVE_SYNC();
        }
    }
}

__device__ __forceinline__ float ret_loggamma(const Params& p, int layer, int dir, int h) { const float x = p.ret_decay[(layer * 2 + dir) * 4 + h]; return -log1pf(expf(-x)); }
__device__ __forceinline__ void ret_phaseA(const Params& p, int layer, int vb, unsigned char* smem) {
    constexpr int RLD = 136;
    const int tid = TIDX, lane = tid & 63, w = tid >> 6, fr = lane & 15, fq = lane >> 4, h = vb & 3, gc = vb >> 2;
    bf16_t* Kt = (bf16_t*)smem; bf16_t* Vt = Kt + 64 * RLD;
    __syncthreads();
#pragma unroll
    for (int i = 0; i < 4; ++i) { const int idx = tid + i * 256, m = idx >> 3, d8 = idx & 7; const bf16_t* src = p.zb + (size_t)(gc * 128 + m) * PROJ + h * 64 + d8 * 8;
        const bf16x8 k8 = *(const bf16x8*)(src + ZRK), v8 = *(const bf16x8*)(src + ZRV);
#pragma unroll
        for (int c = 0; c < 8; ++c) { Kt[(d8 * 8 + c) * RLD + m] = (bf16_t)k8[c]; Vt[(d8 * 8 + c) * RLD + m] = (bf16_t)v8[c]; } }
    __syncthreads();
    const float lgf = ret_loggamma(p, layer, 0, h), lgb = ret_loggamma(p, layer, 1, h);
    f32x4 acc[2][4];
#pragma unroll
    for (int dir = 0; dir < 2; ++dir)
#pragma unroll
        for (int dt = 0; dt < 4; ++dt) acc[dir][dt] = (f32x4){0.f, 0.f, 0.f, 0.f};
#pragma unroll
    for (int ks = 0; ks < 4; ++ks) {
        const int m0 = ks * 32 + fq * 8;
        const bf16x8 v8 = *(const bf16x8*)(Vt + (w * 16 + fr) * RLD + m0);
        bf16x8 af, ab;
#pragma unroll
        for (int j = 0; j < 8; ++j) { const float v = bf2f((bf16_t)v8[j]); af[j] = (short)f2bf(v * __expf(lgf * (float)(127 - (m0 + j)))); ab[j] = (short)f2bf(v * __expf(lgb * (float)(m0 + j))); }
#pragma unroll
        for (int dt = 0; dt < 4; ++dt) { const bf16x8 b = *(const bf16x8*)(Kt + (dt * 16 + fr) * RLD + m0);
            acc[0][dt] = __builtin_amdgcn_mfma_f32_16x16x32_bf16(af, b, acc[0][dt], 0, 0, 0);
            acc[1][dt] = __builtin_amdgcn_mfma_f32_16x16x32_bf16(ab, b, acc[1][dt], 0, 0, 0); }
    }
#pragma unroll
    for (int dir = 0; dir < 2; ++dir) { float* o = L_kv(p, layer) + (((size_t)gc * 4 + h) * 2 + dir) * 4096;
#pragma unroll
        for (int dt = 0; dt < 4; ++dt)
#pragma unroll
            for (int r = 0; r < 4; ++r) o[(w * 16 + fq * 4 + r) * 64 + dt * 16 + fr] = acc[dir][dt][r]; }
}
__device__ __forceinline__ void ret_phaseB(const Params& p, int layer, int vb) {
    const int id = vb * 256 + TIDX; if (id >= p.B * 4 * 2 * 4096) return;
    const int i = id & 4095, dir = (id >> 12) & 1, h = (id >> 13) & 3, b = id >> 15;
    const float g128 = expf(128.f * ret_loggamma(p, layer, dir, h)); float S = 0.f;
    const int npos = p.NCC + p.NLC; constexpr int MAXPOS = 18;
    if (npos <= MAXPOS) {
        float kvv[MAXPOS];
#pragma unroll
        for (int pos = 0; pos < MAXPOS; ++pos) if (pos < npos) { const int gc = order_chunk(p, b, dir, pos); kvv[pos] = L_kv(p, layer)[(((size_t)gc * 4 + h) * 2 + dir) * 4096 + i]; }
#pragma unroll
        for (int pos = 0; pos < MAXPOS; ++pos) if (pos < npos) { const int gc = order_chunk(p, b, dir, pos); L_sin(p, layer)[(((size_t)gc * 4 + h) * 2 + dir) * 4096 + i] = S; S = g128 * S + kvv[pos]; }
    } else
    for (int pos = 0; pos < npos; ++pos) { const int gc = order_chunk(p, b, dir, pos); const size_t o = (((size_t)gc * 4 + h) * 2 + dir) * 4096 + i;
        L_sin(p, layer)[o] = S; S = g128 * S + L_kv(p, layer)[o]; }
}
__device__ __forceinline__ void ret_phaseC(const Params& p, int layer, int vb, unsigned char* smem) {
    const int tid = TIDX, lane = tid & 63, w = tid >> 6, fr = lane & 15, fq = lane >> 4, h = vb & 3, gc = vb >> 2;
    bf16_t* Ks = (bf16_t*)smem; bf16_t* Vt = Ks + 128 * KLD; bf16_t* Sf = Vt + 64 * VLD; bf16_t* Sb = Sf + 64 * KLD;
    const float lgf = ret_loggamma(p, layer, 0, h), lgb = ret_loggamma(p, layer, 1, h);
    const int row0 = gc * 128;
    __syncthreads();
#pragma unroll
    for (int i = 0; i < 4; ++i) { const int idx = tid + i * 256, key = idx >> 3, d8 = idx & 7; const bf16_t* src = p.zb + (size_t)(row0 + key) * PROJ + h * 64 + d8 * 8;
        const bf16x8 kv = *(const bf16x8*)(src + ZRK), vv = *(const bf16x8*)(src + ZRV);
        *(bf16x8*)(Ks + key * KLD + d8 * 8) = kv;
#pragma unroll
        for (int c = 0; c < 8; ++c) Vt[(d8 * 8 + c) * VLD + key] = (bf16_t)vv[c]; }
    { const float* sf = L_sin(p, layer) + (((size_t)gc * 4 + h) * 2) * 4096;
#pragma unroll
      for (int i = 0; i < 8; ++i) { const int idx = tid + i * 256, which = idx >> 10, e = (idx >> 4) & 63, d4 = idx & 15; f32x4 v = *(const f32x4*)(sf + which * 4096 + e * 64 + d4 * 4);
          *(bf16x4*)((which ? Sb : Sf) + e * KLD + d4 * 4) = (bf16x4){(short)f2bf(v[0]), (short)f2bf(v[1]), (short)f2bf(v[2]), (short)f2bf(v[3])}; } }
    __syncthreads();
    bf16x8 qf[2][2]; float wf[2], wb[2];
#pragma unroll
    for (int nt = 0; nt < 2; ++nt) { const int c = w * 32 + nt * 16 + fr; wf[nt] = __expf(lgf * (c + 1)); wb[nt] = __expf(lgb * (128 - c));
#pragma unroll
        for (int ks = 0; ks < 2; ++ks) qf[nt][ks] = *(const bf16x8*)(p.zb + (size_t)(row0 + c) * PROJ + ZRQ + h * 64 + ks * 32 + fq * 8); }
    f32x4 o[4][2];
#pragma unroll
    for (int dt = 0; dt < 4; ++dt) {
        f32x4 xf[2], xb[2]; xf[0] = xf[1] = xb[0] = xb[1] = (f32x4){0.f, 0.f, 0.f, 0.f};
#pragma unroll
        for (int ks = 0; ks < 2; ++ks) { bf16x8 af = *(const bf16x8*)(Sf + (dt * 16 + fr) * KLD + ks * 32 + fq * 8), ab = *(const bf16x8*)(Sb + (dt * 16 + fr) * KLD + ks * 32 + fq * 8);
#pragma unroll
            for (int nt = 0; nt < 2; ++nt) { xf[nt] = __builtin_amdgcn_mfma_f32_16x16x32_bf16(af, qf[nt][ks], xf[nt], 0, 0, 0); xb[nt] = __builtin_amdgcn_mfma_f32_16x16x32_bf16(ab, qf[nt][ks], xb[nt], 0, 0, 0); } }
#pragma unroll
        for (int nt = 0; nt < 2; ++nt) o[dt][nt] = xf[nt] * wf[nt] + xb[nt] * wb[nt];
    }
#pragma unroll 1
    for (int kh = 0; kh < 2; ++kh) {
        f32x4 s[4][2];
#pragma unroll
        for (int mt = 0; mt < 4; ++mt) { s[mt][0] = (f32x4){0.f, 0.f, 0.f, 0.f}; s[mt][1] = s[mt][0];
#pragma unroll
            for (int ks = 0; ks < 2; ++ks) { bf16x8 a = *(const bf16x8*)(Ks + (kh * 64 + mt * 16 + fr) * KLD + ks * 32 + fq * 8);
                s[mt][0] = __builtin_amdgcn_mfma_f32_16x16x32_bf16(a, qf[0][ks], s[mt][0], 0, 0, 0);
                s[mt][1] = __builtin_amdgcn_mfma_f32_16x16x32_bf16(a, qf[1][ks], s[mt][1], 0, 0, 0); } }
#pragma unroll
        for (int nt = 0; nt < 2; ++nt) { const int c = w * 32 + nt * 16 + fr;
#pragma unroll
            for (int mt = 0; mt < 4; ++mt)
#pragma unroll
                for (int r = 0; r < 4; ++r) { const int dlt = c - (kh * 64 + mt * 16 + fq * 4 + r);
                    const float ex = __expf((dlt > 0 ? lgf : lgb) * (float)(dlt > 0 ? dlt : -dlt)); s[mt][nt][r] *= (dlt == 0 ? 2.f : ex); } }
#pragma unroll
        for (int ks2 = 0; ks2 < 2; ++ks2) {
            bf16x8 pb[2];
#pragma unroll
            for (int nt = 0; nt < 2; ++nt)
#pragma unroll
                for (int j = 0; j < 8; ++j) pb[nt][j] = (short)f2bf(s[2 * ks2 + (j >> 2)][nt][j & 3]);
#pragma unroll
            for (int dt = 0; dt < 4; ++dt) { const bf16_t* vp = Vt + (dt * 16 + fr) * VLD + kh * 64 + fq * 4;
                bf16x4 v0 = *(const bf16x4*)(vp + (2 * ks2) * 16), v1 = *(const bf16x4*)(vp + (2 * ks2 + 1) * 16);
                bf16x8 a = (bf16x8){v0[0], v0[1], v0[2], v0[3], v1[0], v1[1], v1[2], v1[3]};
                o[dt][0] = __builtin_amdgcn_mfma_f32_16x16x32_bf16(a, pb[0], o[dt][0], 0, 0, 0);
                o[dt][1] = __builtin_amdgcn_mfma_f32_16x16x32_bf16(a, pb[1], o[dt][1], 0, 0, 0); }
        }
    }
#pragma unroll
    for (int nt = 0; nt < 2; ++nt) { float ss = 0.f;
#pragma unroll
        for (int dt = 0; dt < 4; ++dt)
#pragma unroll
            for (int r = 0; r < 4; ++r) ss += o[dt][nt][r] * o[dt][nt][r];
        ss += __shfl_xor(ss, 16); ss += __shfl_xor(ss, 32);
        const float rstd = rsqrtf(ss * (1.f / 64.f) + EPS); const int row = row0 + w * 32 + nt * 16 + fr;
        bf16x4 gvs[4];
#pragma unroll
        for (int dt = 0; dt < 4; ++dt) gvs[dt] = *(const bf16x4*)(p.zb + (size_t)row * PROJ + ZRG + h * 64 + dt * 16 + fq * 4);
#pragma unroll
        for (int dt = 0; dt < 4; ++dt) { const int e0 = dt * 16 + fq * 4; const bf16x4 gv = gvs[dt]; bf16x4 ov;
#pragma unroll
            for (int r = 0; r < 4; ++r) ov[r] = (short)f2bf(o[dt][nt][r] * rstd * siluf_(bf2f((bf16_t)gv[r])));
            *(bf16x4*)(p.mix + (size_t)row * D + 768 + h * 64 + e0) = ov; }
    }
}

__device__ __forceinline__ float emb(float v, unsigned idx, unsigned mask) { return u2f((f2u(v) & ~mask) | idx); }
__device__ __forceinline__ void cex_desc(float& a, float& b) { const float hi = fmaxf(a, b), lo = fminf(a, b); a = hi; b = lo; }
__device__ __forceinline__ void sort16_desc(float* v) {
#pragma unroll
    for (int k = 2; k <= 16; k <<= 1)
#pragma unroll
        for (int j = k >> 1; j > 0; j >>= 1)
#pragma unroll
            for (int i = 0; i < 16; ++i) { const int l = i ^ j; if (l > i) { if ((i & k) == 0) cex_desc(v[i], v[l]); else cex_desc(v[l], v[i]); } }
}
__device__ __forceinline__ void merge_top16(float* a, const float* b) {
#pragma unroll
    for (int i = 0; i < 16; ++i) a[i] = fmaxf(a[i], b[15 - i]);
#pragma unroll
    for (int j = 8; j > 0; j >>= 1)
#pragma unroll
        for (int i = 0; i < 16; ++i) { const int l = i ^ j; if (l > i) cex_desc(a[i], a[l]); }
}
__device__ __forceinline__ void top16_of_64(float* v) {
    sort16_desc(v); sort16_desc(v + 16); sort16_desc(v + 32); sort16_desc(v + 48);
    merge_top16(v, v + 16); merge_top16(v + 32, v + 48); merge_top16(v, v + 32);
}
__device__ __forceinline__ void peer_score(const Params& p, int layer, int vb, unsigned char* smem) {
    const int lane = TIDX & 63, w = TIDX >> 6, hq = vb & 1, tg = (vb >> 1) & 3, rb = vb >> 3, h = hq * 4 + w;
    const int tok = rb * 128 + tg * 32 + (lane & 31), l5 = lane >> 5;
    float* L = (float*)smem + w * (3 * 16 * 64);
    float* Ls = L; float* Lt1 = L + 1024; float* Lt2 = L + 2048;
    __syncthreads();
#pragma unroll 1
    for (int half = 0; half < 2; ++half) {
        f32x16 acc[4];
#pragma unroll
        for (int mt = 0; mt < 4; ++mt)
#pragma unroll
            for (int r = 0; r < 16; ++r) acc[mt][r] = 0.f;
        const bf16_t* qp = p.pqb + (size_t)tok * D + h * 128 + half * 64 + 8 * l5;
        const bf16_t* kp = p.kb16 + ((((size_t)layer * 2 + half) * 8 + h) * 128 + (lane & 31)) * 64 + 8 * l5;
#pragma unroll
        for (int ks = 0; ks < 4; ++ks) { const bf16x8 b = *(const bf16x8*)(qp + ks * 16);
#pragma unroll
            for (int mt = 0; mt < 4; ++mt) { const bf16x8 a = *(const bf16x8*)(kp + (size_t)mt * 32 * 64 + ks * 16); acc[mt] = __builtin_amdgcn_mfma_f32_32x32x16_bf16(a, b, acc[mt], 0, 0, 0); } }
        float v[64];
#pragma unroll
        for (int mt = 0; mt < 4; ++mt)
#pragma unroll
            for (int r = 0; r < 16; ++r) v[mt * 16 + r] = emb(acc[mt][r], (unsigned)(mt * 32 + (r & 3) + 8 * (r >> 2) + 4 * l5), 127u);
        top16_of_64(v);
#pragma unroll
        for (int i = 0; i < 16; ++i) Ls[i * 64 + lane] = v[i];
        WAVE_SYNC();
        float u[16];
#pragma unroll
        for (int i = 0; i < 16; ++i) u[i] = Ls[i * 64 + (lane ^ 32)];
        WAVE_SYNC();
        merge_top16(v, u);
        float* Lt = half ? Lt2 : Lt1;
#pragma unroll
        for (int i = 0; i < 16; ++i) Lt[i * 64 + lane] = v[i];
    }
    float t1[16], t2[16];
#pragma unroll
    for (int i = 0; i < 16; ++i) { t1[i] = u2f(f2u(Lt1[i * 64 + lane]) & ~127u); t2[i] = u2f(f2u(Lt2[i * 64 + lane]) & ~127u); }
    float c[64];
    {
        int pidx = 0;
#pragma unroll
        for (int i = 0; i < 16; ++i)
#pragma unroll
            for (int j = 0; j < 16; ++j) if ((i + 1) * (j + 1) <= 16) { c[pidx] = emb(t1[i] + t2[j], (unsigned)pidx, 63u); ++pidx; }
#pragma unroll
        for (int q = 50; q < 64; ++q) c[q] = -3.0e38f;
    }
    top16_of_64(c);
    float best[16];
#pragma unroll
    for (int it = 0; it < 16; ++it) best[it] = c[it];
    const float mx = u2f(f2u(best[0]) & ~63u); float e[16], ssum = 0.f;
#pragma unroll
    for (int it = 0; it < 16; ++it) { e[it] = __expf(u2f(f2u(best[it]) & ~63u) - mx); ssum += e[it]; }
    const float inv = 1.f / ssum;
#pragma unroll
    for (int it = 0; it < 16; ++it) {
        if ((it >> 3) == l5) {
            const int pidx = (int)(f2u(best[it]) & 63u); int ii = 0, st = 0;
            { int q = 0;
#pragma unroll
              for (int i = 0; i < 16; ++i) { if (pidx >= q) { ii = i; st = q; } q += 16 / (i + 1); } }
            const int jj = pidx - st;
            const unsigned k1 = f2u(Lt1[ii * 64 + lane]) & 127u, k2 = f2u(Lt2[jj * 64 + lane]) & 127u;
            p.gate[(size_t)tok * 128 + h * 16 + it] = e[it] * inv; L_eidx(p, layer)[(size_t)tok * 128 + h * 16 + it] = (int)(k1 * 128u + k2);
        }
    }
}
struct GuPre { int e[2]; float g[2]; bf16x8 h[8]; };
__device__ __forceinline__ void gu_prefetch(const Params& p, int layer, int vb, GuPre& q) {
    const int lane = TIDX & 63, r = vb * 4 + (TIDX >> 6), sl = lane & 15;
    q.e[0] = L_eidx(p, layer)[(size_t)r * 128 + lane]; q.e[1] = L_eidx(p, layer)[(size_t)r * 128 + 64 + lane];
    q.g[0] = p.gate[(size_t)r * 128 + lane]; q.g[1] = p.gate[(size_t)r * 128 + 64 + lane];
#pragma unroll
    for (int it = 0; it < 4; ++it) { q.h[it * 2] = *(const bf16x8*)(p.hb + (size_t)r * D + it * 256 + sl * 16); q.h[it * 2 + 1] = *(const bf16x8*)(p.hb + (size_t)r * D + it * 256 + sl * 16 + 8); }
}
__device__ __forceinline__ void peer_gather_u(const Params& p, int layer, int vb, unsigned char* smem, GuPre& pre, int vb_next, int half) {
    const int lane = TIDX & 63, w = TIDX >> 6, r = vb * 4 + w, g = lane >> 4, sl = lane & 15;
    int* cl = (int*)smem + w * 512; float* wl = (float*)(cl + 160);
    int* cj = cl + 320;
    const GLOBAL_AS unsigned char* U = (const GLOBAL_AS unsigned char*)(p.ufp8 + (size_t)layer * NEXP * D);
    const GLOBAL_AS float* us = (const GLOBAL_AS float*)(p.uscale + layer * NEXP); const GLOBAL_AS float* vs = (const GLOBAL_AS float*)(p.vscale + layer * NEXP);
    WAVE_SYNC();
    const int e0 = pre.e[0], e1 = pre.e[1];
    const float g0 = pre.g[0], g1 = pre.g[1];
    const bool m0 = (e0 >> 13) == half, m1 = (e1 >> 13) == half;
    const unsigned long long b0 = __ballot(m0), b1 = __ballot(m1), lt = (1ull << lane) - 1ull;
    const int c0 = __popcll(b0), cnt = c0 + __popcll(b1), nb2 = (cnt + 15) >> 4, cntp = nb2 * 16 + 8;
    const int pos0 = __popcll(b0 & lt), pos1 = c0 + __popcll(b1 & lt);
    if (m0) { cl[pos0] = e0; cj[pos0] = lane; }
    if (m1) { cl[pos1] = e1; cj[pos1] = 64 + lane; }
    for (int i = cnt + lane; i < cntp; i += 64) { cl[i] = half << 13; cj[i] = 128 + (i & 31); }
    float us0 = 0.f, vs0 = 0.f, us1 = 0.f, vs1 = 0.f;
    if (m0) { us0 = us[e0]; vs0 = vs[e0]; }
    if (m1) { us1 = us[e1]; vs1 = vs[e1]; }
    f32x2 hreg[32];
#pragma unroll
    for (int it = 0; it < 4; ++it) { const bf16x8 a = pre.h[it * 2], b = pre.h[it * 2 + 1];
#pragma unroll
        for (int m = 0; m < 4; ++m) { hreg[it * 8 + m] = (f32x2){bf2f((bf16_t)a[2 * m]), bf2f((bf16_t)a[2 * m + 1])}; hreg[it * 8 + 4 + m] = (f32x2){bf2f((bf16_t)b[2 * m]), bf2f((bf16_t)b[2 * m + 1])}; } }
    WAVE_SYNC();
    if (vb_next >= 0) gu_prefetch(p, layer, vb_next, pre);
    typedef unsigned u32x4 __attribute__((ext_vector_type(4)));
    constexpr int NB = 2;
    u32x4 qa[NB][4], qb[NB][4];
    auto issue = [&](u32x4 (&q)[NB][4], int b) {
#pragma unroll
        for (int i = 0; i < NB; ++i) { const GLOBAL_AS unsigned char* row = U + (size_t)cl[(b * NB + i) * 4 + g] * D + sl * 16;
#pragma unroll
            for (int it = 0; it < 4; ++it) q[i][it] = *(const GLOBAL_AS u32x4*)(row + it * 256); } };
    auto consume = [&](const u32x4 (&q)[NB][4], int b) {
#pragma unroll
        for (int i = 0; i < NB; ++i) { f32x2 a0 = {0.f, 0.f}, a1 = {0.f, 0.f};
#pragma unroll
            for (int it = 0; it < 4; ++it)
#pragma unroll
                for (int k = 0; k < 4; ++k) { f32x2 lo, hi; fp8x4_to_f32x2(q[i][it][k], lo, hi); a0 += lo * hreg[it * 8 + k * 2]; a1 += hi * hreg[it * 8 + k * 2 + 1]; }
            float acc = (a0[0] + a1[0]) + (a0[1] + a1[1]);
            acc = red16_sum(acc);
            wl[cj[(b * NB + i) * 4 + g]] = acc; } };
    issue(qa, 0);
#pragma unroll 1
    for (int bb = 0; bb < nb2; ++bb) { issue(qb, 2 * bb + 1); consume(qa, 2 * bb); issue(qa, 2 * bb + 2); consume(qb, 2 * bb + 1); }
    WAVE_SYNC();
    if (m0) L_wbuf(p, layer)[(size_t)r * 128 + lane] = g0 * gelu_tanh(wl[lane] * us0) * vs0;
    if (m1) L_wbuf(p, layer)[(size_t)r * 128 + 64 + lane] = g1 * gelu_tanh(wl[lane + 64] * us1) * vs1;
    WAVE_SYNC();
}
#if MEGA
#define GV_FUSE_FINAL 1
#else
#define GV_FUSE_FINAL 0
#endif
__device__ __forceinline__ void peer_gather_v(const Params& p, int layer, int tok0, int xs, unsigned char* smem, float (&wpre)[8], int (&epre)[8], int tok_next) {
    const int lane = TIDX & 63, w = TIDX >> 6, tq = lane >> 4, sub = (lane >> 3) & 1, pc = lane & 7;
    float* wv = (float*)smem + w * 1024; int* ev = (int*)(wv + 512);
    WAVE_SYNC();
#pragma unroll
    for (int i = 0; i < 8; ++i) { wv[i * 64 + lane] = wpre[i]; ev[i * 64 + lane] = epre[i]; }
    WAVE_SYNC();
    if (tok_next >= 0) {
#pragma unroll
        for (int i = 0; i < 8; ++i) { wpre[i] = L_wbuf(p, layer)[(size_t)tok_next * 128 + i * 64 + lane]; epre[i] = L_eidx(p, layer)[(size_t)tok_next * 128 + i * 64 + lane]; } }
    const GLOBAL_AS unsigned char* V = (const GLOBAL_AS unsigned char*)(p.vfp8 + ((size_t)(layer * 8 + xs) * NEXP) * 128);
    typedef unsigned u32x4 __attribute__((ext_vector_type(4)));
    float o[16];
#pragma unroll
    for (int k = 0; k < 16; ++k) o[k] = 0.f;
    constexpr int GB = 8;
    u32x4 qa[GB], qb[GB];
    auto issue = [&](u32x4 (&q)[GB], int b) {
#pragma unroll
        for (int i = 0; i < GB; ++i) q[i] = *(const GLOBAL_AS u32x4*)(V + (unsigned)(ev[tq * 128 + (b * GB + i) * 2 + sub] * 128 + pc * 16)); };
    auto consume = [&](const u32x4 (&q)[GB], int b) {
#pragma unroll
        for (int i = 0; i < GB; ++i) { const float wj = wv[tq * 128 + (b * GB + i) * 2 + sub];
#pragma unroll
            for (int k = 0; k < 4; ++k) { float f[4]; fp8x4_to_f32(q[i][k], f); o[k * 4] += wj * f[0]; o[k * 4 + 1] += wj * f[1]; o[k * 4 + 2] += wj * f[2]; o[k * 4 + 3] += wj * f[3]; } } };
    issue(qa, 0);
    const bool fuse_out = GV_FUSE_FINAL && layer == 1; f32x4 xres[4], gres[4];
#pragma unroll 1
    for (int b = 0; b < 64 / GB - 2; b += 2) { issue(qb, b + 1); consume(qa, b); issue(qa, b + 2); consume(qb, b + 1); }
    issue(qb, 64 / GB - 1); consume(qa, 64 / GB - 2);
    if (fuse_out && sub == 0) { const int row = tok0 + tq; const float* xr = p.out + (size_t)row * D + xs * 128 + pc * 16; const float* g2 = mod_ptr(p, layer, mod_row(p, row), 5) + xs * 128 + pc * 16;
#pragma unroll
        for (int k = 0; k < 4; ++k) { xres[k] = *(const f32x4*)(xr + k * 4); gres[k] = *(const f32x4*)(g2 + k * 4); } }
    consume(qb, 64 / GB - 1);
#pragma unroll
    for (int k = 0; k < 16; ++k) o[k] += shx8(o[k]);
    if (fuse_out) { if (sub == 0) { float* xw = p.out + (size_t)(tok0 + tq) * D + xs * 128 + pc * 16;
#pragma unroll
            for (int k = 0; k < 4; ++k) { f32x4 r4 = xres[k];
#pragma unroll
                for (int j = 0; j < 4; ++j) r4[j] += gres[k][j] * bf2f(f2bf(o[k * 4 + j]));
                *(f32x4*)(xw + k * 4) = r4; } }
        return; }
    if (sub == 0) { bf16x8 a, b;
#pragma unroll
        for (int k = 0; k < 8; ++k) { a[k] = (short)f2bf(o[k]); b[k] = (short)f2bf(o[8 + k]); }
        bf16_t* dst = L_po(p, layer) + (size_t)(tok0 + tq) * D + xs * 128 + pc * 16; *(bf16x8*)dst = a; *(bf16x8*)(dst + 8) = b; }
}
__device__ __forceinline__ void phase_final(const Params& p, int layer, int vb) {
    const int lane = TIDX & 63, r = vb * 4 + (TIDX >> 6);
    const float* g2 = mod_ptr(p, layer, mod_row(p, r), 5); const bf16_t* po = L_po(p, layer) + (size_t)r * D; float* xr = p.out + (size_t)r * D;
    f32x4 v[4], g[4]; bf16x4 pv[4];
#pragma unroll
    for (int i = 0; i < 4; ++i) { const int c0 = i * 256 + lane * 4; v[i] = *(const f32x4*)(xr + c0); pv[i] = *(const bf16x4*)(po + c0); g[i] = *(const f32x4*)(g2 + c0); }
#pragma unroll
    for (int i = 0; i < 4; ++i) { const int c0 = i * 256 + lane * 4;
#pragma unroll
        for (int j = 0; j < 4; ++j) v[i][j] += g[i][j] * bf2f((bf16_t)pv[i][j]);
        *(f32x4*)(xr + c0) = v[i]; }
}

enum { PH_PROLOGUE = 0, PH_NORM1, PH_GEMM_IN, PH_POST, PH_MIXA, PH_MIXB, PH_MIXC, PH_GLU, PH_GEMM_OUT, PH_NORM2, PH_GEMM_PQ, PH_SCORE, PH_GATHER, PH_GV, PH_COUNT, PH_FINAL };
struct Sched { int xidx, NX, rank, nloc; };
__device__ __forceinline__ int rows_out(const Params& p, int layer) { return layer == 0 ? p.NT : p.NTOK; }
template <class F> __device__ __forceinline__ void for_rowblocks(const Sched& sc, int nrb, int nsub, F f) {
    const int tot = ((nrb + sc.NX - 1) / sc.NX) * nsub;
    for (int j = sc.rank; j < tot; j += sc.nloc) { const int rb = (j / nsub) * sc.NX + sc.xidx; if (rb < nrb) f(rb * nsub + j % nsub); }
}
template <class F> __device__ __forceinline__ void for_items(int n, F f) { for (int vb = blockIdx.x; vb < n; vb += gridDim.x) f(vb); }
template <int ph> __device__ __forceinline__ void run_phase(const Params& p, const Sched& sc, int layer, unsigned char* smem, int sub = -1) {
    const int NCH = p.NT / 128, RO = rows_out(p, layer) / 128;
#ifdef DUP_PH
#pragma unroll 1
    for (int dup = 0; dup < (ph == DUP_PH ? 2 : 1); ++dup)
#endif
    if constexpr (ph == PH_PROLOGUE) for_items(prologue_items(p), [&](int vb) { phase_prologue(p, vb, smem); });
    else if constexpr (ph == PH_NORM1) for_rowblocks(sc, NCH, 16, [&](int vb) { phase_norm<0>(p, layer, vb, p.NT); });
    else if constexpr (ph == PH_GEMM_IN) for_rowblocks(sc, NCH, PROJ / 128, [&](int vb) { EpiIn e{&p, layer}; gemm_tile(p.hb, D, p.wt_in + (size_t)layer * D * PROJ, D, D, (vb / (PROJ / 128)) * 128, (vb % (PROJ / 128)) * 128, smem, e); });
    else if constexpr (ph == PH_POST) { }
    else if constexpr (ph == PH_MIXA) {
        if (sub == 0) for_rowblocks(sc, RO, 8, [&](int vb) { const int h = vb & 7, qblk = vb >> 3, row0 = qblk * 128; const bool lat = row0 < p.NTOK;
            const int b = lat ? qblk / p.NLC : (qblk - p.NTOK / 128) / p.NCC, qb = lat ? qblk % p.NLC : -1; attn_item(p, layer, row0, b, qb, h, smem); });
        if (sub == 1) for_rowblocks(sc, NCH, 8, [&](int vb) { s5_phaseA(p, layer, vb, smem); });
        if (sub == 2) for_rowblocks(sc, NCH, 4, [&](int vb) { ret_phaseA(p, layer, vb, smem); });
    }
    else if constexpr (ph == PH_MIXB) for_items((p.B * 2 * 16 * 64) / 256 + (p.B * 4 * 2 * 4096) / 256, [&](int vb) { const int n5 = (p.B * 2 * 16 * 64) / 256; if (vb < n5) s5_phaseB(p, layer, vb); else ret_phaseB(p, layer, vb - n5); });
    else if constexpr (ph == PH_MIXC) { if (sub == 0) for_rowblocks(sc, RO, 4, [&](int vb) { s5_phaseC(p, layer, vb, smem); }); if (sub == 1) for_rowblocks(sc, RO, 4, [&](int vb) { ret_phaseC(p, layer, vb, smem); }); }
    else if constexpr (ph == PH_GLU) for_rowblocks(sc, RO, 2, [&](int vb) { EpiGlu e{p.yg, p.mix, p.s5_glu_b + layer * 256}; gemm_tile(p.yg, 256, p.wt_glu + (size_t)layer * 256 * 256, 256, 256, (vb >> 1) * 128, (vb & 1) * 128, smem, e); });
    else if constexpr (ph == PH_GEMM_OUT) for_rowblocks(sc, RO, 8, [&](int vb) { EpiResidual e = make_epi_residual(p, layer); gemm_tile(p.mix, D, p.wt_out + (size_t)layer * D * D, D, D, (vb >> 3) * 128, (vb & 7) * 128, smem, e); });
    else if constexpr (ph == PH_NORM2) for_rowblocks(sc, RO, 16, [&](int vb) { phase_norm<1>(p, layer, vb, rows_out(p, layer)); });
    else if constexpr (ph == PH_GEMM_PQ) for_rowblocks(sc, RO, 8, [&](int vb) { EpiStoreBf16 e{p.pqb, D}; gemm_tile(p.hb, D, p.wt_pq + (size_t)layer * D * D, D, D, (vb >> 3) * 128, (vb & 7) * 128, smem, e); });
    else if constexpr (ph == PH_SCORE) for_rowblocks(sc, RO, 8, [&](int vb) { peer_score(p, layer, vb, smem); });
    else if constexpr (ph == PH_GATHER) {
        const int tot = ((RO + sc.NX - 1) / sc.NX) * 32;
        auto vb_of = [&](int j) { const int rb = (j / 32) * sc.NX + sc.xidx; return (j < tot && rb < RO) ? rb * 32 + j % 32 : -1; };
        int j = sc.rank; while (j < tot && vb_of(j) < 0) j += sc.nloc;
        if (j < tot) { GuPre pre; gu_prefetch(p, layer, vb_of(j), pre);
            while (j < tot) { int jn = j + sc.nloc; while (jn < tot && vb_of(jn) < 0) jn += sc.nloc;
                peer_gather_u(p, layer, vb_of(j), smem, pre, vb_of(jn), sub); j = jn; } }
    }
    else if constexpr (ph == PH_GV) {
        const int ntok = RO * 128, w = TIDX >> 6;
        const int lane = TIDX & 63; float wpre[8]; int epre[8];
        for (int xs = sc.xidx; xs < 8; xs += sc.NX) { const int t0 = (sc.rank * 4 + w) * 4;
            if (t0 < ntok) {
#pragma unroll
                for (int i = 0; i < 8; ++i) { wpre[i] = L_wbuf(p, layer)[(size_t)t0 * 128 + i * 64 + lane]; epre[i] = L_eidx(p, layer)[(size_t)t0 * 128 + i * 64 + lane]; } }
            for (int t = t0; t < ntok; t += sc.nloc * 16) { const int tn = t + sc.nloc * 16; peer_gather_v(p, layer, t, xs, smem, wpre, epre, tn < ntok ? tn : -1); } }
    }
    else if constexpr (ph == PH_FINAL) for_rowblocks(sc, p.NTOK / 128, 32, [&](int vb) { phase_final(p, layer, vb); });
}

#ifdef CPU_EMU
#define DECL_SMEM unsigned char* smem = EMU_DYN_SMEM()
#else
#define DECL_SMEM extern __shared__ __attribute__((aligned(16))) unsigned char smem[]
#endif

template <int ph> __global__ void __launch_bounds__(NTHREADS, 2) k_phase(Params p, int layer) {
    DECL_SMEM;
    Sched sc; sc.xidx = 0; sc.NX = 1; sc.rank = blockIdx.x; sc.nloc = gridDim.x;
    for (int sub = 0; sub < 4; ++sub) { if (sub == 0 || (ph == PH_MIXA && sub < 3) || (ph == PH_MIXC && sub < 2) || ph == PH_GATHER) run_phase<ph>(p, sc, layer, smem, sub); }
}

#ifdef CPU_EMU
#define GRID_SYNC() do { (void)nsync; emu::grid_sync(); } while (0)
#define XCD_SYNC() GRID_SYNC()
#define OPAQUE_S(x)
#else
#define XB_TMO      128
#define XB_XCNT(j)  (256  + 64 * (j))
#define XB_XSUB(j)  (1280 + 64 * (j))
#define XB_XGEN(j)  (2304 + 64 * (j))
#define XB_TOP      3328
#define XB_TOPGEN   3392
#define XCD_BAR_WORDS 3456
#define XB_SPIN_CAP (1u << 18)
#define LAS __attribute__((address_space(3)))

__device__ __forceinline__ unsigned xb_ld(unsigned* p)              { return __hip_atomic_load(p, __ATOMIC_RELAXED, __HIP_MEMORY_SCOPE_AGENT); }
__device__ __forceinline__ unsigned xb_add(unsigned* p, unsigned v) { return __hip_atomic_fetch_add(p, v, __ATOMIC_RELAXED, __HIP_MEMORY_SCOPE_AGENT); }
__device__ __forceinline__ unsigned xb_xcc_id() { return (unsigned)__builtin_amdgcn_s_getreg((3 << 11) | 20) & 0xFu; }
#define XB_SPIN(cond, bar) do { unsigned _sp = 0; while (cond) { __builtin_amdgcn_s_sleep(1); \
    if ((++_sp & 255u) == 0u) { if (xb_ld(&(bar)[XB_TMO])) break; if (_sp > XB_SPIN_CAP) { atomicAdd(&(bar)[XB_TMO], 1u); break; } } } } while (0)

struct XcdBarrier {
    unsigned* bar; unsigned x;
    volatile LAS unsigned* st;
};

__device__ __forceinline__ XcdBarrier xcd_barrier_post(unsigned* bar, volatile LAS unsigned* st) {
    XcdBarrier b; b.bar = bar; b.x = xb_xcc_id(); b.st = st;
    if (threadIdx.x == 0) (void)xb_add(&bar[XB_XCNT(b.x)], 1u);
    return b;
}
__device__ __forceinline__ void xcd_barrier_complete(unsigned* bar, unsigned x, unsigned& nloc, unsigned& nx) {
    const unsigned G = gridDim.x * gridDim.y * gridDim.z;
    unsigned sum, cnt, mine, sp = 0u;
    for (;;) {
        sum = 0u; cnt = 0u; mine = 0u;
#pragma unroll
        for (unsigned j = 0; j < 16; ++j) { const unsigned c = xb_ld(&bar[XB_XCNT(j)]); sum += c; cnt += (c > 0u) ? 1u : 0u; mine = (j == x) ? c : mine; }
        if (sum == G) break;
        __builtin_amdgcn_s_sleep(1);
        if ((++sp & 255u) == 0u) { if (xb_ld(&bar[XB_TMO])) break; if (sp > XB_SPIN_CAP) { atomicAdd(&bar[XB_TMO], 1u); break; } }
    }
    nloc = mine > 0u ? mine : 1u; nx = cnt > 0u ? cnt : 1u;
}

template <bool LOCAL> __device__ __forceinline__ void xcd_barrier(const XcdBarrier& b) {
    asm volatile("s_waitcnt vmcnt(0)" ::: "memory");
    __syncthreads();
    if (threadIdx.x == 0) {
        unsigned* bar = b.bar;
        __builtin_amdgcn_s_waitcnt(0);
        unsigned nloc = b.st[0], nx = b.st[1];
        if (nloc == 0u) { xcd_barrier_complete(bar, b.x, nloc, nx); b.st[0] = nloc; b.st[1] = nx; }
        const unsigned old = xb_add(&bar[XB_XSUB(b.x)], 1u);
        const unsigned gen = old / nloc;
        if (old + 1u == (gen + 1u) * nloc) {
            if constexpr (!LOCAL) {
            __builtin_amdgcn_fence(__ATOMIC_RELEASE, "agent");
            asm volatile("s_waitcnt vmcnt(0)" ::: "memory");
            const unsigned og = xb_add(&bar[XB_TOP], 1u);
            const unsigned tg = og / nx;
            if (og + 1u == (tg + 1u) * nx) xb_add(&bar[XB_TOPGEN], 1u);
            else XB_SPIN(xb_ld(&bar[XB_TOPGEN]) == tg, bar);
            }
            __builtin_amdgcn_fence(__ATOMIC_ACQUIRE, "agent");
            xb_add(&bar[XB_XGEN(b.x)], 1u);
            asm volatile("s_waitcnt vmcnt(0)" ::: "memory");
        } else {
            XB_SPIN(xb_ld(&bar[XB_XGEN(b.x)]) == gen, bar);
            __builtin_amdgcn_fence(__ATOMIC_ACQUIRE, "agent");
            asm volatile("s_waitcnt vmcnt(0)" ::: "memory");
        }
    }
    __syncthreads();
}

#define GRID_SYNC() do { XcdBarrier b_; b_.bar = p.bar + 2048; b_.x = (unsigned)scw[0]; b_.st = (volatile LAS unsigned*)(smem + SCHED_OFF + 64); xcd_barrier<false>(b_); } while (0)
#define XCD_SYNC() do { XcdBarrier b_; b_.bar = p.bar + 2048; b_.x = (unsigned)scw[0]; b_.st = (volatile LAS unsigned*)(smem + SCHED_OFF + 64); xcd_barrier<true>(b_); } while (0)
#define OPAQUE_S(x) do { asm volatile("" : "+v"(x)); x = __builtin_amdgcn_readfirstlane(x); } while (0)
#endif
#ifndef ONE_PER_CU_MASK
#define ONE_PER_CU_MASK 0
#endif
constexpr int PARAMS_OFF = 66560;
constexpr int SCHED_OFF = PARAMS_OFF + 1024;
static_assert(PARAMS_OFF + sizeof(Params) <= SCHED_OFF && SCHED_OFF + 128 <= LDS_BYTES, "Params copy must fit");
__global__ void __launch_bounds__(NTHREADS, 2) k_mega(Params p_arg) {
    DECL_SMEM;
    if (threadIdx.x == 0) *(Params*)(smem + PARAMS_OFF) = p_arg;
    __syncthreads();
    const Params& p = *(const Params*)(smem + PARAMS_OFF);
    volatile int* scw = (volatile int*)(smem + SCHED_OFF);
#ifndef CPU_EMU
    volatile LAS unsigned* xb_st = (volatile LAS unsigned*)(smem + SCHED_OFF + 64);
    if (threadIdx.x == 0) { xb_st[0] = 0u; xb_st[1] = 0u; xb_st[2] = 0u; xb_st[3] = 0u; }
    __syncthreads();
    (void)xcd_barrier_post(p.bar + 2048, xb_st);
#else
    unsigned nsync = 0u;
#endif
    if (threadIdx.x == 0) {
#ifdef CPU_EMU
        const unsigned xcc = blockIdx.x % 8u;
        const unsigned rank = atomicAdd(p.bar + 64 + xcc, 1u);
#else
        const unsigned xcc = (unsigned)__builtin_amdgcn_s_getreg((3 << 11) | 20) & 0xFu;
        const unsigned rank = __hip_atomic_fetch_add(p.bar + 64 + xcc, 1u, __ATOMIC_RELAXED, __HIP_MEMORY_SCOPE_AGENT);
#endif
        scw[0] = (int)xcc; scw[1] = (int)rank;
#ifndef CPU_EMU
        const unsigned hw = (unsigned)__builtin_amdgcn_s_getreg(((8 - 1) << 11) | (8 << 6) | 4);
        const unsigned curank = __hip_atomic_fetch_add(p.bar + 128 + ((xcc << 8) | (hw & 0xFFu)), 1u, __ATOMIC_RELAXED, __HIP_MEMORY_SCOPE_AGENT);
        unsigned arank = 0xFFFFu; if (curank == 0u) arank = __hip_atomic_fetch_add(p.bar + 96 + xcc, 1u, __ATOMIC_RELAXED, __HIP_MEMORY_SCOPE_AGENT);
        scw[5] = (int)curank; scw[6] = (int)arank; scw[8] = (int)((xcc << 8) | (hw & 0xFFu));
        if (curank == 0u) __hip_atomic_store(p.bar + 5632 + ((xcc << 8) | (hw & 0xFFu)), arank, __ATOMIC_RELAXED, __HIP_MEMORY_SCOPE_AGENT);
#else
        scw[5] = 0; scw[6] = (int)rank;
#endif
    }
#ifdef CPU_EMU
    emu::grid_sync();
#else
    asm volatile("s_waitcnt vmcnt(0)" ::: "memory");
    cooperative_groups::this_grid().sync();
#endif
    if (threadIdx.x == 0) {
        const int xcc = scw[0]; int nx = 0, xi = 0, nl = 1;
        for (int j = 0; j < 16; ++j) {
#ifdef CPU_EMU
            const unsigned c = p.bar[64 + j];
#else
            const unsigned c = __hip_atomic_load(p.bar + 64 + j, __ATOMIC_RELAXED, __HIP_MEMORY_SCOPE_AGENT);
#endif
            if (c) { if (j < xcc) ++xi; ++nx; } if (j == xcc) nl = (int)c; }
        scw[2] = xi; scw[3] = nx; scw[4] = nl;
#ifndef CPU_EMU
        scw[7] = (int)__hip_atomic_load(p.bar + 96 + xcc, __ATOMIC_RELAXED, __HIP_MEMORY_SCOPE_AGENT);
        if (scw[7] * 2 == nl && scw[5] < 2) { const int cidx = scw[5] == 0 ? scw[6] : (int)__hip_atomic_load(p.bar + 5632 + scw[8], __ATOMIC_RELAXED, __HIP_MEMORY_SCOPE_AGENT);
            if (cidx >= 0 && cidx < scw[7]) scw[1] = cidx + scw[7] * scw[5]; }
#else
        scw[7] = nl;
#endif
    }
    __syncthreads();
    { Sched sc; sc.xidx = UNIFORM(scw[2]); sc.NX = UNIFORM(scw[3]); sc.rank = UNIFORM(scw[1]); sc.nloc = UNIFORM(scw[4]); run_phase<PH_PROLOGUE>(p, sc, 0, smem); GRID_SYNC(); }
    for (int step = 1; step < 1 + 2 * (PH_COUNT - 1); ++step) {
        int ph = 1 + (step - 1) % (PH_COUNT - 1), layer = (step - 1) / (PH_COUNT - 1);
        if (ph == PH_POST) continue;
        OPAQUE_S(ph); OPAQUE_S(layer);
        Sched sc; sc.xidx = UNIFORM(scw[2]); sc.NX = UNIFORM(scw[3]); sc.rank = UNIFORM(scw[1]); sc.nloc = UNIFORM(scw[4]);
        if ((ONE_PER_CU_MASK >> ph) & 1) {
            if (scw[5] != 0) { GRID_SYNC(); continue; }
            sc.rank = scw[6]; sc.nloc = scw[7];
        }
        switch (ph) {
            case PH_NORM1: run_phase<PH_NORM1>(p, sc, layer, smem); break;
            case PH_GEMM_IN: run_phase<PH_GEMM_IN>(p, sc, layer, smem); break;
            case PH_POST: run_phase<PH_POST>(p, sc, layer, smem); break;
            case PH_MIXA: run_phase<PH_MIXA>(p, sc, layer, smem, 0); XCD_SYNC(); run_phase<PH_MIXA>(p, sc, layer, smem, 1); XCD_SYNC(); run_phase<PH_MIXA>(p, sc, layer, smem, 2); break;
            case PH_MIXB: run_phase<PH_MIXB>(p, sc, layer, smem); break;
            case PH_MIXC: run_phase<PH_MIXC>(p, sc, layer, smem, 0); XCD_SYNC(); run_phase<PH_MIXC>(p, sc, layer, smem, 1); break;
            case PH_GLU: run_phase<PH_GLU>(p, sc, layer, smem); break;
            case PH_GEMM_OUT: run_phase<PH_GEMM_OUT>(p, sc, layer, smem); break;
            case PH_NORM2: run_phase<PH_NORM2>(p, sc, layer, smem); break;
            case PH_GEMM_PQ: run_phase<PH_GEMM_PQ>(p, sc, layer, smem); break;
            case PH_SCORE: run_phase<PH_SCORE>(p, sc, layer, smem); break;
            case PH_GATHER: for (int qt = 0; qt < 2; ++qt) { run_phase<PH_GATHER>(p, sc, layer, smem, qt); if (qt < 1) XCD_SYNC(); } break;
            default: run_phase<PH_GV>(p, sc, layer, smem); break;
        }
        if (ph == PH_GV && layer == 1) break;
        if (ph == PH_NORM1 || ph == PH_MIXC || ph == PH_GLU || ph == PH_GEMM_OUT || ph == PH_NORM2 || ph == PH_GEMM_PQ || ph == PH_SCORE) XCD_SYNC(); else GRID_SYNC();
    }
}

#ifdef CPU_EMU
extern "C" void emu_check(const char* name, const float* data, long rows, long cols, long ld);
extern "C" void emu_check2(const char* name, const float* data, long rows, long cols, long ld, long rcols, long rcol0);
static void emu_check_bf16(const char* name, const bf16_t* d, long rows, long cols, long ld, long col0, long rcols) {
    float* t = (float*)malloc(rows * cols * 4); for (long r = 0; r < rows; ++r) for (long c = 0; c < cols; ++c) t[r * cols + c] = bf2f(d[r * ld + col0 + c]);
    emu_check2(name, t, rows, cols, cols, rcols, col0); free(t);
}
#endif

static size_t carve(size_t& off, size_t bytes) { size_t o = off; off += (bytes + 255) / 256 * 256; return o; }

extern "C" void kernel_launch(void* const* d_in, const int* in_sizes, int n_in, void* d_out, int out_size, void* d_ws, size_t ws_size, hipStream_t stream) {
    Params p{};
    const float** fp = (const float**)&p.x;
    for (int i = 0; i < 28; ++i) fp[i] = (const float*)d_in[i];
    p.out = (float*)d_out;
    p.B = in_sizes[1] / D; p.SEQ = in_sizes[0] / (p.B * D); p.CTX = in_sizes[2] / (p.B * D);
    p.NTOK = p.B * p.SEQ; p.NCTX = p.B * p.CTX; p.NT = p.NTOK + p.NCTX; p.NLC = p.SEQ / 128; p.NCC = p.CTX / 128;
    char* ws = (char*)d_ws; size_t off = 0; const size_t NT = p.NT, NCH = NT / 128;
    p.mod = (float*)(ws + carve(off, 2 * (p.B + 1) * NMOD * D * 4));
    p.ropeA = (float*)(ws + carve(off, (size_t)p.SEQ * 64 * 4)); p.ropeR = (float*)(ws + carve(off, (size_t)p.SEQ * 64 * 4));
    p.wt_in = (bf16_t*)(ws + carve(off, 2ull * D * PROJ * 2)); p.wt_out = (bf16_t*)(ws + carve(off, 2ull * D * D * 2));
    p.wt_pq = (bf16_t*)(ws + carve(off, 2ull * D * D * 2)); p.wt_glu = (bf16_t*)(ws + carve(off, 2ull * 256 * 256 * 2));
    p.hb = (bf16_t*)(ws + carve(off, NT * D * 2)); p.mix = (bf16_t*)(ws + carve(off, NT * D * 2)); p.yg = (bf16_t*)(ws + carve(off, NT * 256 * 2));
    p.zb = (bf16_t*)(ws + carve(off, NT * PROJ * 2));
    p.pqb = (bf16_t*)(ws + carve(off, NT * D * 2)); p.kb16 = (bf16_t*)(ws + carve(off, 2 * 2 * 8 * 128 * 64 * 2));
    p.ufp8 = (unsigned char*)(ws + carve(off, 2ull * NEXP * D)); p.vfp8 = (unsigned char*)(ws + carve(off, 2ull * NEXP * D));
    p.s5_pt = (bf16_t*)(ws + carve(off, 64ull * 128 * 128 * 2)); p.s5_bc = (float*)(ws + carve(off, 64ull * 64 * 16 * 2 * 4)); p.s5_ab = (float*)(ws + carve(off, 64ull * 64 * 4 * 4)); p.s5_cm = (bf16_t*)(ws + carve(off, 64ull * 16 * 128 * 2)); p.s5_bcb = (bf16_t*)(ws + carve(off, 64ull * 128 * 16 * 2));
    p.uscale = (float*)(ws + carve(off, 2 * NEXP * 4)); p.vscale = (float*)(ws + carve(off, 2 * NEXP * 4));
    p.ctxs = (float*)(ws + carve(off, (size_t)p.NCTX * D * 4));
    p.s5_hend = (float*)(ws + carve(off, 2 * NCH * 4096 * 4)); p.s5_hin = (float*)(ws + carve(off, 2 * NCH * 4096 * 4));
    p.ret_kv = (float*)(ws + carve(off, 2 * NCH * 32768 * 4)); p.ret_sin = (float*)(ws + carve(off, 2 * NCH * 32768 * 4));
    p.akv = (bf16_t*)(ws + carve(off, 2 * NT * 256 * 2)); p.bar = (unsigned*)(ws + carve(off, 32768));
    p.ytmp = (float*)(bf16_t*)p.pqb;     p.gate = (float*)(ws + carve(off, NT * 128 * 4)); p.eidx = (int*)(ws + carve(off, 2 * NT * 128 * 4));
    p.wbuf = (float*)(ws + carve(off, 2 * NT * 128 * 4)); p.avt = (bf16_t*)(ws + carve(off, 2 * NT * 128 * 2)); p.po = (bf16_t*)(ws + carve(off, 2 * NT * D * 2));
    if (off > ws_size) { fprintf(stderr, "workspace too small: need %zu have %zu\n", off, ws_size); return; }
#if MEGA
#ifdef CPU_EMU
    memset(p.bar, 0, 32768);
    EMU_LAUNCH_COOP(k_mega, 16, NTHREADS, LDS_BYTES, stream, p);
#else
    static int grid_blocks = 0;
    if (!grid_blocks) {
        int dev = 0, cus = 0, per_cu = 0;
        (void)hipGetDevice(&dev); (void)hipDeviceGetAttribute(&cus, hipDeviceAttributeMultiprocessorCount, dev);
        (void)hipFuncSetAttribute((const void*)k_mega, hipFuncAttributeMaxDynamicSharedMemorySize, LDS_BYTES);
        (void)hipOccupancyMaxActiveBlocksPerMultiprocessor(&per_cu, (const void*)k_mega, NTHREADS, LDS_BYTES);
        if (per_cu > 2) per_cu = 2;
        grid_blocks = cus * per_cu;
    }
    (void)hipMemsetAsync(p.bar, 0, 32768, stream);
    void* args[] = {&p};
    hipError_t e = hipLaunchCooperativeKernel((const void*)k_mega, dim3(grid_blocks), dim3(NTHREADS), args, LDS_BYTES, stream);
    if (e != hipSuccess) fprintf(stderr, "cooperative launch failed: %s (grid %d)\n", hipGetErrorString(e), grid_blocks);
#endif
#else
#ifdef CPU_EMU
    const int grid = 64;
#define RUN(ph, layer) EMU_LAUNCH(k_phase<ph>, grid, NTHREADS, LDS_BYTES, stream, p, layer)
#else
    const int grid = 512;
#define RUN(ph, layer) do { (void)hipFuncSetAttribute((const void*)k_phase<ph>, hipFuncAttributeMaxDynamicSharedMemorySize, LDS_BYTES); hipLaunchKernelGGL(k_phase<ph>, dim3(grid), dim3(NTHREADS), LDS_BYTES, stream, p, layer); } while (0)
#endif
    RUN(PH_PROLOGUE, 0);
#ifdef CPU_EMU
    emu_check("mod0", p.mod, p.B + 1, NMOD * D, NMOD * D);
#define CHK(code) if (layer == 0) { code; }
#else
#define CHK(code)
#endif
    for (int layer = 0; layer < 2; ++layer) {
        RUN(PH_NORM1, layer);
#ifdef CPU_EMU
        if (layer == 1) { emu_check("x2_0", p.out, p.NTOK, D, D); emu_check("ctx2_0", p.ctxs, p.NCTX, D, D); }
#endif
        RUN(PH_GEMM_IN, layer);
        RUN(PH_MIXA, layer); CHK(emu_check_bf16("mix0", p.mix, NT, 512, D, 0, D))
        RUN(PH_MIXB, layer);
        RUN(PH_MIXC, layer); CHK(emu_check_bf16("mix0", p.mix, NT, 256, D, 768, D))
        RUN(PH_GLU, layer); CHK(emu_check_bf16("mix0", p.mix, NT, 256, D, 512, D))
        RUN(PH_GEMM_OUT, layer); CHK(emu_check("x1_0", p.out, p.NTOK, D, D))
        RUN(PH_NORM2, layer); CHK(emu_check_bf16("h2_0", p.hb, p.NTOK, D, D, 0, D))
        RUN(PH_GEMM_PQ, layer);
        RUN(PH_SCORE, layer); CHK(float* t = (float*)malloc(NT * 128 * 4); for (size_t i = 0; i < (size_t)p.NTOK * 128; ++i) t[i] = (float)p.eidx[i]; emu_check("eidx0", t, p.NTOK, 128, 128); free(t); emu_check("gate0", p.gate, p.NTOK, 128, 128))
        RUN(PH_GATHER, layer); RUN(PH_GV, layer);
    }
    RUN(PH_FINAL, 1);
#endif
}
```
